# Optimizing an MI355X kernel written in HIP

```python
import math
import jax, jax.numpy as jnp
from jax import lax
import numpy as np

D_MODEL = 2048
BATCH = 4
SEQ = 4096
DEPTH = 4

CHUNK = 64
N_MIXERS = 2
RMS_EPS = 1e-6

GLA_HEADS = 4
GLA_QK = D_MODEL // 2
GLA_V = D_MODEL
GLA_DK = GLA_QK // GLA_HEADS
GLA_DV = GLA_V // GLA_HEADS
GLA_GATE_RANK = 16
GLA_GATE_TAU = 16.0
GLA_IN = 2 * GLA_QK + 2 * GLA_V + GLA_GATE_RANK

DSA_HEADS = 16
DSA_LATENT = 256
DSA_DV = D_MODEL // DSA_HEADS
IDX_HEADS = 16
IDX_DIM = 128
TOPK_MAX = 256
Q_BLOCK = 128
DSA_IN = DSA_HEADS * DSA_LATENT + DSA_LATENT + IDX_HEADS * IDX_DIM + IDX_DIM + IDX_HEADS

REL_BUCKETS = 32
REL_MAX_DIST = 128

D_FF = -(-8 * D_MODEL // (3 * 256)) * 256

N_GLA = (DEPTH + 1) // 2
N_DSA = DEPTH // 2

kernel_name = "hybrid_gla_dsa_streaming_trunk"


def rmsnorm(x, g):
    xf = x.astype(jnp.float32)
    y = xf * lax.rsqrt(jnp.mean(xf * xf, axis=-1, keepdims=True) + RMS_EPS)
    return (y * g.astype(jnp.float32)).astype(x.dtype)


def t5_bucket(rel):
    nb = REL_BUCKETS // 2
    max_exact = nb // 2
    ret = (rel > 0).astype(jnp.int32) * nb
    n = jnp.abs(rel)
    large = max_exact + (jnp.log(jnp.maximum(n, 1).astype(jnp.float32) / max_exact)
                         / math.log(REL_MAX_DIST / max_exact) * (nb - max_exact)).astype(jnp.int32)
    large = jnp.minimum(large, nb - 1)
    return ret + jnp.where(n < max_exact, n, large)


def gla_mixer(h, w_in, w_a2, b_a, g_norm, w_out):
    B, T, _ = h.shape
    proj = h @ w_in
    q, k, v, g, a = jnp.split(proj, [GLA_QK, 2 * GLA_QK, 2 * GLA_QK + GLA_V, 2 * GLA_QK + 2 * GLA_V], axis=-1)
    q = q.reshape(B, T, GLA_HEADS, GLA_DK) * (GLA_DK ** -0.5)
    k = k.reshape(B, T, GLA_HEADS, GLA_DK)
    v = v.reshape(B, T, GLA_HEADS, GLA_DV)
    log_alpha = jax.nn.log_sigmoid((a @ w_a2 + b_a).astype(jnp.float32)) / GLA_GATE_TAU
    log_alpha = log_alpha.reshape(B, T, GLA_HEADS, GLA_DK)
    nc = T // CHUNK

    def to_chunks(z):
        return jnp.moveaxis(z.reshape(B, nc, CHUNK, *z.shape[2:]), 1, 0)

    def step(state, xs):
        qc, kc, vc, lac = xs
        lcum = jnp.cumsum(lac, axis=1)
        ltot = lcum[:, -1]
        kd = kc.astype(jnp.float32) * jnp.exp(ltot[:, None] - lcum)
        state = state * jnp.exp(ltot)[..., None] + jnp.einsum('bchk,bchv->bhkv', kd, vc.astype(jnp.float32))
        oc = jnp.einsum('bchk,bhkv->bchv', qc.astype(jnp.float32), state)
        return state, oc

    s0 = jnp.zeros((B, GLA_HEADS, GLA_DK, GLA_DV), jnp.float32)
    _, o = lax.scan(step, s0, (to_chunks(q), to_chunks(k), to_chunks(v), to_chunks(log_alpha)))
    o = jnp.moveaxis(o, 0, 1).reshape(B, T, GLA_HEADS, GLA_DV)
    o = rmsnorm(o, g_norm).reshape(B, T, GLA_V).astype(h.dtype)
    o = o * jax.nn.silu(g)
    return o @ w_out


def dsa_mixer(h, w_in, kv_norm, kidx_norm, w_uv, w_out, rel_bias):
    B, T, _ = h.shape
    proj = h @ w_in
    s1 = DSA_HEADS * DSA_LATENT
    s2 = s1 + DSA_LATENT
    s3 = s2 + IDX_HEADS * IDX_DIM
    s4 = s3 + IDX_DIM
    q, c, qi, ki, wi = jnp.split(proj, [s1, s2, s3, s4], axis=-1)
    q = q.reshape(B, T, DSA_HEADS, DSA_LATENT)
    c = rmsnorm(c, kv_norm)
    qi = qi.reshape(B, T, IDX_HEADS, IDX_DIM)
    ki = rmsnorm(ki, kidx_norm).astype(jnp.float32)
    wi = wi * (IDX_HEADS ** -0.5)
    k_sel = min(TOPK_MAX, T // 4)
    pos = jnp.arange(T, dtype=jnp.int32)
    key_chunk = pos // CHUNK
    nb = T // Q_BLOCK
    c32 = c.astype(jnp.float32)
    w_uv32 = w_uv.astype(jnp.float32)

    def blk(z):
        return jnp.moveaxis(z.reshape(B, nb, Q_BLOCK, *z.shape[2:]), 1, 0)

    def attend(xs):
        qb, qib, wib, tq = xs
        sc = jax.nn.relu(jnp.einsum('bqhd,bsd->bqhs', qib.astype(jnp.float32), ki) * (IDX_DIM ** -0.5))
        score = jnp.einsum('bqhs,bqh->bqs', sc, wib.astype(jnp.float32))
        q_chunk = tq // CHUNK
        adm = key_chunk[None, :] <= q_chunk[:, None]
        score = jnp.where(adm[None], score, -jnp.inf)
        _, idx = lax.top_k(score, k_sel)
        c_sel = jax.vmap(lambda cb, ib: cb[ib])(c32, idx)
        logits = jnp.einsum('bqhd,bqkd->bqhk', qb.astype(jnp.float32), c_sel) * (DSA_LATENT ** -0.5)
        bias = rel_bias.astype(jnp.float32)[t5_bucket(idx - tq[None, :, None])]
        logits = logits + jnp.swapaxes(bias, -1, -2)
        valid = (idx // CHUNK) <= q_chunk[None, :, None]
        logits = jnp.where(valid[:, :, None, :], logits, -jnp.inf)
        p = jax.nn.softmax(logits, axis=-1)
        ob = jnp.einsum('bqhk,bqkd->bqhd', p, c_sel)
        return jnp.einsum('bqhd,hde->bqhe', ob, w_uv32)

    o = lax.map(attend, (blk(q), blk(qi), blk(wi), pos.reshape(nb, Q_BLOCK)))
    o = jnp.moveaxis(o, 0, 1).reshape(B, T, DSA_HEADS * DSA_DV).astype(h.dtype)
    return o @ w_out


def swiglu(h, w1, w3, w2):
    return (jax.nn.silu(h @ w1) * (h @ w3)) @ w2


def setup_inputs(seed: int = 0) -> dict:
    key = jax.random.key(seed)
    ks = jax.random.split(key, 24)
    f32 = jnp.float32

    def nrm(k, shape, scale):
        return jax.random.normal(k, shape, f32) * scale

    out_scale = (2.0 * DEPTH) ** -0.5
    return {
        "x": nrm(ks[0], (BATCH, SEQ, D_MODEL), 1.0),
        "norm_mix": 1.0 + nrm(ks[1], (DEPTH, D_MODEL), 0.05),
        "norm_ffn": 1.0 + nrm(ks[2], (DEPTH, D_MODEL), 0.05),
        "norm_final": 1.0 + nrm(ks[3], (D_MODEL,), 0.05),
        "gla_w_in": nrm(ks[4], (N_GLA, D_MODEL, GLA_IN), D_MODEL ** -0.5),
        "gla_w_a2": nrm(ks[5], (N_GLA, GLA_GATE_RANK, GLA_QK), GLA_GATE_RANK ** -0.5),
        "gla_b_a": nrm(ks[6], (N_GLA, GLA_QK), 0.1),
        "gla_g_norm": 1.0 + nrm(ks[7], (N_GLA, GLA_DV), 0.05),
        "gla_w_out": nrm(ks[8], (N_GLA, GLA_V, D_MODEL), GLA_V ** -0.5 * out_scale),
        "dsa_w_in": nrm(ks[9], (N_DSA, D_MODEL, DSA_IN), D_MODEL ** -0.5),
        "dsa_kv_norm": 1.0 + nrm(ks[10], (N_DSA, DSA_LATENT), 0.05),
        "dsa_kidx_norm": 1.0 + nrm(ks[11], (N_DSA, IDX_DIM), 0.05),
        "dsa_w_uv": nrm(ks[12], (N_DSA, DSA_HEADS, DSA_LATENT, DSA_DV), DSA_LATENT ** -0.5),
        "dsa_w_out": nrm(ks[13], (N_DSA, DSA_HEADS * DSA_DV, D_MODEL), (DSA_HEADS * DSA_DV) ** -0.5 * out_scale),
        "rel_bias": nrm(ks[14], (REL_BUCKETS, DSA_HEADS), 0.5),
        "ffn_w1": nrm(ks[15], (DEPTH, D_MODEL, D_FF), D_MODEL ** -0.5),
        "ffn_w3": nrm(ks[16], (DEPTH, D_MODEL, D_FF), D_MODEL ** -0.5),
        "ffn_w2": nrm(ks[17], (DEPTH, D_FF, D_MODEL), D_FF ** -0.5 * out_scale),
    }


def reference(x, norm_mix, norm_ffn, norm_final,
              gla_w_in, gla_w_a2, gla_b_a, gla_g_norm, gla_w_out,
              dsa_w_in, dsa_kv_norm, dsa_kidx_norm, dsa_w_uv, dsa_w_out,
              rel_bias, ffn_w1, ffn_w3, ffn_w2):
    for i in range(DEPTH):
        h = rmsnorm(x, norm_mix[i])
        j = i // N_MIXERS
        if i % N_MIXERS == 0:
            y = gla_mixer(h, gla_w_in[j], gla_w_a2[j], gla_b_a[j], gla_g_norm[j], gla_w_out[j])
        else:
            y = dsa_mixer(h, dsa_w_in[j], dsa_kv_norm[j], dsa_kidx_norm[j], dsa_w_uv[j], dsa_w_out[j], rel_bias)
        x = x + y
        x = x + swiglu(rmsnorm(x, norm_ffn[i]), ffn_w1[i], ffn_w3[i], ffn_w2[i])
    return rmsnorm(x, norm_final)
```

```cpp
#include <hip/hip_runtime.h>
#include <hip/hip_cooperative_groups.h>
#include <cstdio>
#include <cstdint>
namespace cg = cooperative_groups;

#ifndef PH_MASK
#define PH_MASK 0xFFFF
#endif
#define PHON(k) ((PH_MASK >> (k)) & 1)
#ifndef REP_MASK
#define REP_MASK 0
#endif
#ifndef MK_MULTI
#define MK_MULTI 0
#endif

#define LAS __attribute__((address_space(3)))
typedef unsigned short bf16_t;
typedef short bf16x8 __attribute__((ext_vector_type(8)));
typedef short s16x4 __attribute__((ext_vector_type(4)));
typedef float f32x4 __attribute__((ext_vector_type(4)));
typedef float f32x16 __attribute__((ext_vector_type(16)));
typedef unsigned u32x4 __attribute__((ext_vector_type(4)));
typedef unsigned u32x2 __attribute__((ext_vector_type(2)));
typedef int i32x4 __attribute__((ext_vector_type(4)));

constexpr int NB = 4, T = 4096, M = NB * T, D = 2048, FF = 5632;
constexpr int P1_LD = 4352, P1_Q = 0, P1_K = 1024, P1_G = 2048, P1_A = 4096;
constexpr int P2_LD = 6656, P2_Q = 0, P2_C = 4096, P2_QI = 4352, P2_KI = 6400, P2_WI = 6528;
constexpr float RMS_EPS = 1e-6f;

constexpr size_t MiB = 1u << 20;
constexpr size_t WS_W = 1 * MiB;
constexpr size_t GLA_STRIDE = 33 * MiB, GLA_WINA = 0, GLA_WV = 17 * MiB, GLA_WOUT = 25 * MiB;
constexpr size_t DSA_BASE = WS_W + 66 * MiB, DSA_STRIDE = 36 * MiB, DSA_WIN = 0, DSA_WUV = 26 * MiB, DSA_WOUT = 28 * MiB;
constexpr size_t FFN_BASE = WS_W + 138 * MiB, FFN_STRIDE = 66 * MiB, FFN_W13 = 0, FFN_W2 = 44 * MiB;
constexpr size_t WS_H = 403 * MiB, WS_P = 467 * MiB, WS_VT = 603 * MiB, WS_X2 = 675 * MiB;
constexpr size_t WS_KDT = WS_X2, WS_DEC = WS_X2 + 32 * MiB, WS_O = WS_X2 + 33 * MiB;
constexpr size_t WS_CN = WS_X2, WS_KI = WS_X2 + 8 * MiB, WS_WI = WS_X2 + 12 * MiB, WS_IDX = WS_X2 + 13 * MiB, WS_OB = WS_X2 + 29 * MiB;
constexpr size_t WS_XR = 832 * MiB;
constexpr size_t WS_END = 896 * MiB;
constexpr int LDS_BYTES = 163840, LDS_CTL = 163584;

struct Params { const float* in[18]; float* out; unsigned char* ws; int ph_lo, ph_hi; };
struct Ctx { int tid, lane, wave, bid, G; unsigned char* ws; };

__device__ __forceinline__ float bf2f(bf16_t u) { return __builtin_bit_cast(float, (unsigned)u << 16); }
__device__ __forceinline__ float bflo(unsigned u) { return __builtin_bit_cast(float, u << 16); }
__device__ __forceinline__ float bfhi(unsigned u) { return __builtin_bit_cast(float, u & 0xffff0000u); }
typedef __bf16 bf16x2_t __attribute__((ext_vector_type(2)));
typedef float f32x2_t __attribute__((ext_vector_type(2)));
__device__ __forceinline__ unsigned pk2(float lo, float hi) { const f32x2_t v = {lo, hi}; const bf16x2_t b = __builtin_convertvector(v, bf16x2_t); return __builtin_bit_cast(unsigned, b); }
__device__ __forceinline__ float wave_sum(float v) {
#pragma unroll
    for (int o = 1; o < 64; o <<= 1) v += __shfl_xor(v, o);
    return v;
}
__device__ __forceinline__ f32x4 mfma16(bf16x8 a, bf16x8 b, f32x4 c) { return __builtin_amdgcn_mfma_f32_16x16x32_bf16(a, b, c, 0, 0, 0); }
__device__ __forceinline__ f32x16 mfma32(bf16x8 a, bf16x8 b, f32x16 c) { return __builtin_amdgcn_mfma_f32_32x32x16_bf16(a, b, c, 0, 0, 0); }

namespace pg8 {
constexpr int BM = 256, BK = 64, HALF = 128, HTB = HALF * BK * 2, STAGE_BYTES = 8 * HTB, NXCD = 8, WGM = 8;
__host__ __device__ __forceinline__ int lds_byte(int r, int c) { const int st = (r >> 4) * 2 + (c >> 5), rr = r & 15, cc = c & 31, ob = rr * 64 + cc * 2; return st * 1024 + (ob ^ (((ob >> 9) & 1) << 5)); }
__host__ __device__ __forceinline__ void stage_rc(int b, int& R, int& C) { const int st = b / 1024, sb = b % 1024, swz = sb ^ (((sb >> 9) & 1) << 5); R = (st >> 1) * 16 + swz / 64; C = (st & 1) * 32 + (swz % 64) / 2; }
__host__ __device__ __forceinline__ int perm32(int rho) { const int n = rho >> 4, i = rho & 15; return 8 * (i >> 2) + 4 * n + (i & 3); }

struct Unit { int pm, pn; };
struct Gemm { const bf16_t* A; const bf16_t* Bt; int M, N, K, lda, ldb, apn; };

struct StaticOrder {
    int nM, nN, nwg, G, c;
    __device__ void init(int M_, int N_, int G_, int c_) { nM = M_ / BM; nN = N_ / BM; nwg = nM * nN; G = G_; c = c_; }
    __device__ bool next(int i, Unit& u) const {
        const long L = (long)i * G + c; if (L >= nwg) return false;
        int wgid = (int)L; { const int q = nwg / NXCD, r = nwg % NXCD, xcd = wgid % NXCD, off = wgid / NXCD; wgid = (xcd < r ? xcd * (q + 1) : r * (q + 1) + (xcd - r) * q) + off; }
        const int nig = WGM * nN, gid = wgid / nig, fm = gid * WGM, gsz = (nM - fm) < WGM ? (nM - fm) : WGM;
        u.pm = fm + ((wgid % nig) % gsz); u.pn = (wgid % nig) / gsz; return true;
    }
};

struct EpiStore {
    bf16_t* O; int ldc;
    __device__ __forceinline__ void operator()(const f32x4 (&acc)[2][2][4][2], const Unit& u, int wr, int wc, int fr, int fq) const {
        const int row0 = u.pm * BM + wr * 64 + fr, col0 = u.pn * BM + wc * 32 + 8 * fq;
#pragma unroll
        for (int ai = 0; ai < 2; ++ai)
#pragma unroll
            for (int m = 0; m < 4; ++m) { bf16_t* rowp = O + (size_t)(row0 + ai * HALF + m * 16) * ldc + col0;
#pragma unroll
                for (int bj = 0; bj < 2; ++bj) { const f32x4 v0 = acc[ai][bj][m][0], v1 = acc[ai][bj][m][1];
                    u32x4 w; w.x = pk2(v0[0], v0[1]); w.y = pk2(v0[2], v0[3]); w.z = pk2(v1[0], v1[1]); w.w = pk2(v1[2], v1[3]);
                    *(u32x4*)(rowp + bj * HALF) = w; } }
    }
};
struct EpiResid {
    const float* xin_f; bf16_t* xr;
    __device__ __forceinline__ void operator()(const f32x4 (&acc)[2][2][4][2], const Unit& u, int wr, int wc, int fr, int fq) const {
        const int row0 = u.pm * BM + wr * 64 + fr, col0 = u.pn * BM + wc * 32 + 8 * fq;
#pragma unroll
        for (int ai = 0; ai < 2; ++ai)
#pragma unroll
            for (int m = 0; m < 4; ++m) { const size_t ro = (size_t)(row0 + ai * HALF + m * 16) * D + col0;
#pragma unroll
                for (int bj = 0; bj < 2; ++bj) { f32x4 a0, a1;
                    if (xin_f) { a0 = *(const f32x4*)(xin_f + ro + bj * HALF); a1 = *(const f32x4*)(xin_f + ro + bj * HALF + 4); }
                    else { const u32x4 xv = *(const u32x4*)(xr + ro + bj * HALF); a0 = (f32x4){bflo(xv.x), bfhi(xv.x), bflo(xv.y), bfhi(xv.y)}; a1 = (f32x4){bflo(xv.z), bfhi(xv.z), bflo(xv.w), bfhi(xv.w)}; }
                    const f32x4 o0 = a0 + acc[ai][bj][m][0], o1 = a1 + acc[ai][bj][m][1];
                    u32x4 w; w.x = pk2(o0[0], o0[1]); w.y = pk2(o0[2], o0[3]); w.z = pk2(o1[0], o1[1]); w.w = pk2(o1[2], o1[3]);
                    *(u32x4*)(xr + ro + bj * HALF) = w; } }
    }
};
struct EpiSwiglu {
    bf16_t* U;
    __device__ __forceinline__ void operator()(const f32x4 (&acc)[2][2][4][2], const Unit& u, int wr, int wc, int fr, int fq) const {
        const int row0 = u.pm * BM + wr * 64 + fr, col0 = u.pn * 128 + wc * 16 + 4 * fq;
#pragma unroll
        for (int ai = 0; ai < 2; ++ai)
#pragma unroll
            for (int m = 0; m < 4; ++m) { bf16_t* rowp = U + (size_t)(row0 + ai * HALF + m * 16) * FF + col0;
#pragma unroll
                for (int bj = 0; bj < 2; ++bj) { const f32x4 g = acc[ai][bj][m][0], v = acc[ai][bj][m][1]; float o[4];
#pragma unroll
                    for (int i = 0; i < 4; ++i) { const float e = __builtin_amdgcn_exp2f(-1.44269504089f * g[i]); o[i] = g[i] * __builtin_amdgcn_rcpf(1.0f + e) * v[i]; }
                    u32x2 w; w.x = pk2(o[0], o[1]); w.y = pk2(o[2], o[3]);
                    *(u32x2*)(rowp + bj * 64) = w; } }
    }
};

template <class Epi, class Sched>
__device__ __forceinline__ void gemm_phase(LAS unsigned char* lds, const Gemm g, const Sched& S, const Epi& E, const int tid) {
    const int wid = __builtin_amdgcn_readfirstlane(tid >> 6), lane = tid & 63, wr = wid >> 2, wc = wid & 3, fr = lane & 15, fq = lane >> 4;
    const int K = g.K, nt = K / BK;
    unsigned voffA[2], voffB[2];
#pragma unroll
    for (int i = 0; i < 2; ++i) { int R, C; stage_rc(tid * 16 + i * 8192, R, C); const int Rb = (R & ~31) + perm32(R & 31);
        voffA[i] = (unsigned)(R * g.lda + C) * 2u; voffB[i] = (unsigned)(Rb * g.ldb + C) * 2u; }
    const size_t kstep = (size_t)(BK * 2);
    const size_t hstepA = (size_t)HALF * g.lda * 2, hstepB = (size_t)HALF * g.ldb * 2;
    const size_t tstepA = 2 * hstepA, tstepB = 2 * hstepB, pnA = (size_t)g.apn * 2;
    const unsigned ldsw = (unsigned)wid * 1024u;
    const int aoff = lds_byte(wr * 64 + fr, fq * 8), boff = lds_byte(wc * 32 + fr, fq * 8);
#define PG8_SA(b, h) (((b) * 2 + (h)) * HTB)
#define PG8_SB(b, h) ((4 + (b) * 2 + (h)) * HTB)
#define PG8_STAGE(bufoff, gbase, voff) do { _Pragma("unroll") for (int _i = 0; _i < 2; ++_i) \
        __builtin_amdgcn_global_load_lds((const unsigned*)((const char*)(gbase) + (voff)[_i]), (LAS unsigned*)(lds + (bufoff) + ldsw + _i * 8192), 16, 0, 0); } while (0)
#define PG8_LDA(dst, b, h) do { _Pragma("unroll") for (int m = 0; m < 4; ++m) _Pragma("unroll") for (int k = 0; k < 2; ++k) dst[m][k] = *(const LAS bf16x8*)(lds + PG8_SA(b, h) + aoff + m * 2048 + k * 1024); } while (0)
#define PG8_LDB(dst, b, h) do { _Pragma("unroll") for (int n = 0; n < 2; ++n) _Pragma("unroll") for (int k = 0; k < 2; ++k) dst[n][k] = *(const LAS bf16x8*)(lds + PG8_SB(b, h) + boff + n * 2048 + k * 1024); } while (0)
#define PG8_MMA(ai, bj, At, Bt) do { __builtin_amdgcn_s_setprio(1); _Pragma("unroll") for (int m = 0; m < 4; ++m) _Pragma("unroll") for (int n = 0; n < 2; ++n) _Pragma("unroll") for (int k = 0; k < 2; ++k) \
        acc[ai][bj][m][n] = __builtin_amdgcn_mfma_f32_16x16x32_bf16(Bt[n][k], At[m][k], acc[ai][bj][m][n], 0, 0, 0); __builtin_amdgcn_s_setprio(0); } while (0)
#define PG8_WAIT_V(n) asm volatile("s_waitcnt vmcnt(" #n ")" ::: "memory")
#define PG8_WAIT_L(n) asm volatile("s_waitcnt lgkmcnt(" #n ")" ::: "memory")
#define PG8_BAR __builtin_amdgcn_s_barrier()
#define PG8_SCHED __builtin_amdgcn_sched_barrier(0)
    Unit cur, nxt; int ui = 0;
    if (!S.next(0, cur)) return;
    f32x4 acc[2][2][4][2];
#pragma unroll
    for (int a = 0; a < 2; ++a)
#pragma unroll
        for (int b = 0; b < 2; ++b)
#pragma unroll
            for (int m = 0; m < 4; ++m)
#pragma unroll
                for (int n = 0; n < 2; ++n) acc[a][b][m][n] = (f32x4){0.f, 0.f, 0.f, 0.f};
    bf16x8 At[4][2], B0[2][2], B1[2][2];
    const char* cA = (const char*)g.A + (size_t)cur.pm * tstepA + (size_t)cur.pn * pnA; const char* cB = (const char*)g.Bt + (size_t)cur.pn * tstepB;
    PG8_STAGE(PG8_SB(0, 0), cB, voffB); PG8_STAGE(PG8_SB(0, 1), cB + hstepB, voffB); PG8_STAGE(PG8_SA(0, 0), cA, voffA); PG8_STAGE(PG8_SA(0, 1), cA + hstepA, voffA);
    if (wr == 1) PG8_BAR;
    PG8_WAIT_V(2); PG8_BAR;
    PG8_STAGE(PG8_SB(1, 0), cB + kstep, voffB); PG8_STAGE(PG8_SA(1, 0), cA + kstep, voffA); PG8_STAGE(PG8_SB(1, 1), cB + hstepB + kstep, voffB);
    PG8_WAIT_V(6); PG8_BAR;
    for (;;) {
        const bool has_next = S.next(ui + 1, nxt);
        const char* nA = has_next ? (const char*)g.A + (size_t)nxt.pm * tstepA + (size_t)nxt.pn * pnA : cA; const char* nB = has_next ? (const char*)g.Bt + (size_t)nxt.pn * tstepB : cB;
        for (int t = 0; t < nt; t += 2) {
            const bool last = (t == nt - 2);
            const char* a1 = cA + (size_t)(t + 1) * kstep;
            const char* a2 = last ? nA : cA + (size_t)(t + 2) * kstep; const char* b2 = last ? nB : cB + (size_t)(t + 2) * kstep;
            const char* a3 = a2 + kstep; const char* b3 = b2 + kstep;
            PG8_LDB(B0, 0, 0); PG8_LDB(B1, 0, 1); PG8_SCHED; PG8_LDA(At, 0, 0); PG8_STAGE(PG8_SA(1, 1), a1 + hstepA, voffA);
            PG8_WAIT_V(8); PG8_WAIT_L(0); PG8_BAR; PG8_MMA(0, 0, At, B0); PG8_MMA(0, 1, At, B1); PG8_BAR; PG8_SCHED;
            PG8_LDA(At, 0, 1); PG8_STAGE(PG8_SB(0, 0), b2, voffB); PG8_STAGE(PG8_SB(0, 1), b2 + hstepB, voffB); PG8_STAGE(PG8_SA(0, 0), a2, voffA);
            PG8_WAIT_V(8); PG8_WAIT_L(0); PG8_BAR; PG8_MMA(1, 0, At, B0); PG8_MMA(1, 1, At, B1); PG8_BAR; PG8_SCHED;
            PG8_LDB(B0, 1, 0); PG8_LDB(B1, 1, 1); PG8_SCHED; PG8_LDA(At, 1, 0); PG8_STAGE(PG8_SA(0, 1), a2 + hstepA, voffA);
            PG8_WAIT_V(8); PG8_WAIT_L(0); PG8_BAR; PG8_MMA(0, 0, At, B0); PG8_MMA(0, 1, At, B1); PG8_BAR; PG8_SCHED;
            PG8_LDA(At, 1, 1); PG8_STAGE(PG8_SB(1, 0), b3, voffB); PG8_STAGE(PG8_SB(1, 1), b3 + hstepB, voffB); PG8_STAGE(PG8_SA(1, 0), a3, voffA);
            PG8_WAIT_V(8); PG8_WAIT_L(0); PG8_BAR; PG8_MMA(1, 0, At, B0); PG8_MMA(1, 1, At, B1); PG8_BAR; PG8_SCHED;
        }
        if (wr == 0) PG8_BAR;
        E(acc, cur, wr, wc, fr, fq);
        if (!has_next) break;
#pragma unroll
        for (int a = 0; a < 2; ++a)
#pragma unroll
            for (int b = 0; b < 2; ++b)
#pragma unroll
                for (int m = 0; m < 4; ++m)
#pragma unroll
                    for (int n = 0; n < 2; ++n) acc[a][b][m][n] = (f32x4){0.f, 0.f, 0.f, 0.f};
        cur = nxt; cA = nA; cB = nB; ++ui;
        if (wr == 1) PG8_BAR;
    }
    PG8_WAIT_V(0);
    PG8_BAR;
#undef PG8_SA
#undef PG8_SB
#undef PG8_STAGE
#undef PG8_LDA
#undef PG8_LDB
#undef PG8_MMA
#undef PG8_WAIT_V
#undef PG8_WAIT_L
#undef PG8_BAR
#undef PG8_SCHED
}
}

struct TrSeg { const float* W; int ldw, ncols, K; bf16_t* WT; int ldt, row_off, mode; };
__device__ __forceinline__ void tr_item(const TrSeg& s, int kb, int nb, LAS float* scr, int lane) {
    const int k0 = 64 * kb, n0 = 64 * nb;
    const int c4 = (lane & 15) * 4, kq = lane >> 4;
    const bool okc = (n0 + c4) < s.ncols;
    const float* src = s.W + (size_t)(k0 + kq) * s.ldw + n0 + c4;
    f32x4 v[16];
#pragma unroll
    for (int i = 0; i < 16; ++i) v[i] = okc ? *(const f32x4*)(src + (size_t)(4 * i) * s.ldw) : (f32x4){0.f, 0.f, 0.f, 0.f};
#pragma unroll
    for (int i = 0; i < 16; ++i) { LAS float* d = scr + (4 * i + kq) * 65 + c4; d[0] = v[i][0]; d[1] = v[i][1]; d[2] = v[i][2]; d[3] = v[i][3]; }
    asm volatile("s_waitcnt lgkmcnt(0)" ::: "memory");
    const int c = lane & 7;
#pragma unroll
    for (int j = 0; j < 8; ++j) { const int n = (lane >> 3) + 8 * j, gn = n0 + n; const LAS float* sp = scr + (8 * c) * 65 + n;
        u32x4 o; o.x = pk2(sp[0 * 65], sp[1 * 65]); o.y = pk2(sp[2 * 65], sp[3 * 65]); o.z = pk2(sp[4 * 65], sp[5 * 65]); o.w = pk2(sp[6 * 65], sp[7 * 65]);
        const int row = s.mode ? (8 * (gn >> 2) + (gn & 3) + s.row_off) : (s.row_off + gn);
        if (gn < s.ncols) *(u32x4*)(s.WT + (size_t)row * s.ldt + k0 + 8 * c) = o; }
    asm volatile("s_waitcnt lgkmcnt(0)" ::: "memory");
}
__device__ __forceinline__ void tr_run(const TrSeg& s, int& next, int& base, int NGW, LAS float* scr, int lane) {
    const int nnb = (s.ncols + 63) >> 6, n = (s.K >> 6) * nnb;
    while (next < base + n) { const int it = next - base; tr_item(s, it / nnb, it % nnb, scr, lane); next += NGW; }
    base += n;
}
__device__ __forceinline__ void prologue_phase(const Params& p, const Ctx& cx, LAS unsigned char* lds) {
    const int wave = cx.wave, lane = cx.lane, G = cx.G, gw = cx.bid * 8 + wave, NGW = G * 8;
    LAS float* scr = (LAS float*)(lds + wave * 16640);
    unsigned char* ws = cx.ws;
    int next = gw, base = 0;
    for (int j = 0; j < 2; ++j) {
        const float* w_in = p.in[4] + (size_t)j * D * 6160;
        bf16_t* WinA = (bf16_t*)(ws + WS_W + j * GLA_STRIDE + GLA_WINA); bf16_t* Wv = (bf16_t*)(ws + WS_W + j * GLA_STRIDE + GLA_WV); bf16_t* Wo = (bf16_t*)(ws + WS_W + j * GLA_STRIDE + GLA_WOUT);
        { TrSeg s{w_in, 6160, 2048, D, WinA, D, 0, 0}; tr_run(s, next, base, NGW, scr, lane); }
        { TrSeg s{w_in + 2048, 6160, 2048, D, Wv, D, 0, 0}; tr_run(s, next, base, NGW, scr, lane); }
        { TrSeg s{w_in + 4096, 6160, 2048, D, WinA, D, 2048, 0}; tr_run(s, next, base, NGW, scr, lane); }
        { TrSeg s{w_in + 6144, 6160, 16, D, WinA, D, 4096, 0}; tr_run(s, next, base, NGW, scr, lane); }
        { TrSeg s{p.in[8] + (size_t)j * D * D, D, D, D, Wo, D, 0, 0}; tr_run(s, next, base, NGW, scr, lane); }
    }
    for (int j = 0; j < 2; ++j) {
        bf16_t* Win = (bf16_t*)(ws + DSA_BASE + j * DSA_STRIDE + DSA_WIN); bf16_t* Wuv = (bf16_t*)(ws + DSA_BASE + j * DSA_STRIDE + DSA_WUV); bf16_t* Wo = (bf16_t*)(ws + DSA_BASE + j * DSA_STRIDE + DSA_WOUT);
        { TrSeg s{p.in[9] + (size_t)j * D * 6544, 6544, 6544, D, Win, D, 0, 0}; tr_run(s, next, base, NGW, scr, lane); }
        for (int h = 0; h < 16; ++h) {
            TrSeg s{p.in[12] + (size_t)(j * 16 + h) * 256 * 128, 128, 128, 256, Wuv + (size_t)((h >> 1) * 256 + (h & 1) * 128) * 512 + (h & 1) * 256, 512, 0, 0};
            tr_run(s, next, base, NGW, scr, lane);
        }
        { TrSeg s{p.in[13] + (size_t)j * D * D, D, D, D, Wo, D, 0, 0}; tr_run(s, next, base, NGW, scr, lane); }
        for (int i = cx.bid * 512 + cx.tid; i < 65536; i += G * 512) {
            const int blk = i >> 12, r = (i >> 5) & 127, ch = i & 31, pn = blk >> 1, hh = blk & 1;
            *(u32x4*)(Wuv + (size_t)(pn * 256 + hh * 128 + r) * 512 + (1 - hh) * 256 + ch * 8) = (u32x4){0u, 0u, 0u, 0u};
        }
    }
    for (int i = 0; i < 4; ++i) {
        bf16_t* W13 = (bf16_t*)(ws + FFN_BASE + i * FFN_STRIDE + FFN_W13); bf16_t* W2 = (bf16_t*)(ws + FFN_BASE + i * FFN_STRIDE + FFN_W2);
        { TrSeg s{p.in[15] + (size_t)i * D * FF, FF, FF, D, W13, D, 0, 1}; tr_run(s, next, base, NGW, scr, lane); }
        { TrSeg s{p.in[16] + (size_t)i * D * FF, FF, FF, D, W13, D, 4, 1}; tr_run(s, next, base, NGW, scr, lane); }
        { TrSeg s{p.in[17] + (size_t)i * FF * D, D, D, FF, W2, FF, 0, 0}; tr_run(s, next, base, NGW, scr, lane); }
    }
}

template <bool BF16IN, bool F32OUT>
__device__ __forceinline__ void rms_phase(const void* xp, const float* g, void* outp, const Ctx& cx) {
    const int lane = cx.lane, gw = cx.bid * 8 + cx.wave, NGW = cx.G * 8;
    f32x4 gv[8], nx[8];
#pragma unroll
    for (int j = 0; j < 8; ++j) gv[j] = ((const f32x4*)g)[lane + 64 * j];
#define RMS_LOAD(ROW) do { if (BF16IN) { const u32x2* xr_ = (const u32x2*)((const bf16_t*)xp + (size_t)(ROW) * D) + lane; \
            _Pragma("unroll") for (int j = 0; j < 8; ++j) { const u32x2 t_ = xr_[64 * j]; nx[j] = (f32x4){bflo(t_.x), bfhi(t_.x), bflo(t_.y), bfhi(t_.y)}; } } \
        else { const f32x4* xr_ = (const f32x4*)((const float*)xp + (size_t)(ROW) * D) + lane; _Pragma("unroll") for (int j = 0; j < 8; ++j) nx[j] = xr_[64 * j]; } } while (0)
    if (gw < M) RMS_LOAD(gw);
    for (int m = gw; m < M; m += NGW) {
        f32x4 v[8]; float s = 0.f;
#pragma unroll
        for (int j = 0; j < 8; ++j) v[j] = nx[j];
        if (m + NGW < M) RMS_LOAD(m + NGW);
#pragma unroll
        for (int j = 0; j < 8; ++j) s += (v[j][0] * v[j][0] + v[j][1] * v[j][1]) + (v[j][2] * v[j][2] + v[j][3] * v[j][3]);
        s = wave_sum(s);
        const float r = 1.0f / sqrtf(s * (1.0f / D) + RMS_EPS);
        if (F32OUT) { f32x4* o = (f32x4*)((float*)outp + (size_t)m * D) + lane;
#pragma unroll
            for (int j = 0; j < 8; ++j) o[64 * j] = v[j] * r * gv[j];
        } else { u32x2* o = (u32x2*)((bf16_t*)outp + (size_t)m * D) + lane;
#pragma unroll
            for (int j = 0; j < 8; ++j) { const f32x4 y = v[j] * r * gv[j]; u32x2 w; w.x = pk2(y[0], y[1]); w.y = pk2(y[2], y[3]); o[64 * j] = w; } }
    }
#undef RMS_LOAD
}
__device__ __forceinline__ float fexp(float x) { return __builtin_amdgcn_exp2f(x * 1.44269504089f); }
__device__ __forceinline__ float log_sigmoid(float z) { return fminf(z, 0.f) - __builtin_amdgcn_logf(1.0f + fexp(-fabsf(z))) * 0.69314718056f; }
__device__ __forceinline__ void gla_gate_phase(const Params& p, const Ctx& cx, int j, LAS unsigned char* lds) {
    const bf16_t* P1 = (const bf16_t*)(cx.ws + WS_P); bf16_t* KDT = (bf16_t*)(cx.ws + WS_KDT); float* DEC = (float*)(cx.ws + WS_DEC);
    const bf16_t* H = (const bf16_t*)(cx.ws + WS_H); const bf16_t* Wa = (const bf16_t*)(cx.ws + WS_W + (size_t)j * GLA_STRIDE + GLA_WINA) + (size_t)4096 * D;
    const float* w_a2 = p.in[5] + (size_t)j * 16 * 1024; const float* b_a = p.in[6] + (size_t)j * 1024;
    const int wave = cx.wave, lane = cx.lane, fr = lane & 15, fq = lane >> 4;
    LAS float* al = (LAS float*)(lds + 32768);
    for (int it = cx.bid; it < 512; it += cx.G) {
        const int bc = it >> 1, kcol = (it & 1) * 512 + cx.tid, b = bc >> 6, c = bc & 63, tok0 = b * T + c * 64;
        __syncthreads();
        {
            f32x4 acc[4];
#pragma unroll
            for (int tt = 0; tt < 4; ++tt) acc[tt] = (f32x4){0.f, 0.f, 0.f, 0.f};
            const bf16_t* hp = H + (size_t)(tok0 + fr) * D + 256 * wave + 8 * fq;
            const bf16_t* wp = Wa + (size_t)fr * D + 256 * wave + 8 * fq;
#pragma unroll
            for (int ss = 0; ss < 8; ++ss) { const bf16x8 bfg = *(const bf16x8*)(wp + 32 * ss);
#pragma unroll
                for (int tt = 0; tt < 4; ++tt) { const bf16x8 afg = *(const bf16x8*)(hp + (size_t)(16 * tt) * D + 32 * ss); acc[tt] = mfma16(afg, bfg, acc[tt]); } }
#pragma unroll
            for (int tt = 0; tt < 4; ++tt) *(LAS f32x4*)(lds + ((wave * 4 + tt) * 64 + lane) * 16) = acc[tt];
        }
        __syncthreads();
        if (cx.tid < 256) { const int tt = cx.tid >> 6, l2 = cx.tid & 63;
            f32x4 v = *(const LAS f32x4*)(lds + (tt * 64 + l2) * 16);
#pragma unroll
            for (int w8 = 1; w8 < 8; ++w8) v = v + *(const LAS f32x4*)(lds + ((w8 * 4 + tt) * 64 + l2) * 16);
            const int tokl = 16 * tt + 4 * (l2 >> 4), r = l2 & 15;
#pragma unroll
            for (int i = 0; i < 4; ++i) al[(tokl + i) * 16 + r] = v[i]; }
        __syncthreads();
        float w[16];
#pragma unroll
        for (int r = 0; r < 16; ++r) w[r] = w_a2[r * 1024 + kcol];
        const float bias = b_a[kcol];
        float cum = 0.f;
        for (int t = 0; t < 64; ++t) {
            const LAS f32x4* ap = (const LAS f32x4*)(al + t * 16); const f32x4 a0 = ap[0], a1 = ap[1], a2 = ap[2], a3 = ap[3];
            float z = bias;
#pragma unroll
            for (int r = 0; r < 4; ++r) { z += a0[r] * w[r] + a1[r] * w[4 + r]; z += a2[r] * w[8 + r] + a3[r] * w[12 + r]; }
            cum += log_sigmoid(z) * (1.0f / 16.0f);
        }
        const float ltot = cum; cum = 0.f;
        for (int t8 = 0; t8 < 8; ++t8) {
            float kd[8];
#pragma unroll
            for (int e = 0; e < 8; ++e) {
                const int t = 8 * t8 + e;
                const LAS f32x4* ap = (const LAS f32x4*)(al + t * 16); const f32x4 a0 = ap[0], a1 = ap[1], a2 = ap[2], a3 = ap[3];
                float z = bias;
#pragma unroll
                for (int r = 0; r < 4; ++r) { z += a0[r] * w[r] + a1[r] * w[4 + r]; z += a2[r] * w[8 + r] + a3[r] * w[12 + r]; }
                cum += log_sigmoid(z) * (1.0f / 16.0f);
                kd[e] = bf2f(P1[(size_t)(tok0 + t) * P1_LD + P1_K + kcol]) * fexp(ltot - cum);
            }
            u32x4 o; o.x = pk2(kd[0], kd[1]); o.y = pk2(kd[2], kd[3]); o.z = pk2(kd[4], kd[5]); o.w = pk2(kd[6], kd[7]);
            *(u32x4*)(KDT + (size_t)kcol * M + tok0 + 8 * t8) = o;
        }
        DEC[(size_t)bc * 1024 + kcol] = fexp(ltot);
    }
}

constexpr int SC_KDB = 144, SC_QB = 528, SC_KD_BYTES = 256 * SC_KDB, SC_DEC_OFF = SC_KD_BYTES + 64 * SC_QB, SC_BUF = SC_DEC_OFF + 1024, SC_PART = SC_BUF;
__device__ __forceinline__ void gla_scan_phase(const Params& p, const Ctx& cx, LAS unsigned char* lds) {
    const bf16_t* P1 = (const bf16_t*)(cx.ws + WS_P); const bf16_t* VT = (const bf16_t*)(cx.ws + WS_VT); const bf16_t* KDT = (const bf16_t*)(cx.ws + WS_KDT);
    const float* DEC = (const float*)(cx.ws + WS_DEC); bf16_t* O = (bf16_t*)(cx.ws + WS_O);
    const int tid = cx.tid, wave = cx.wave, lane = cx.lane, G = cx.G, fr = lane & 15, fq = lane >> 4;
    const int vt = wave & 1, kq = wave >> 1;
    for (int item = cx.bid; item < 256; item += G) {
        int bh, vg; if (G == 256) { const int r_ = item >> 3; bh = (item & 7) + 8 * (r_ >> 4); vg = r_ & 15; } else { bh = item >> 4; vg = item & 15; }
        const int b = bh >> 2, h = bh & 3, v0 = vg * 32 + vt * 16;
        const bf16_t* gk = KDT + (size_t)(h * 256 + (tid >> 3)) * M + b * T + (tid & 7) * 8;
        const bf16_t* gq = P1 + (size_t)(b * T + (tid >> 5)) * P1_LD + P1_Q + h * 256 + (tid & 31) * 8;
        const float* gd = DEC + (size_t)(b * 64) * 1024 + h * 256 + (tid & 63) * 4;
        const int lk = (tid >> 3) * SC_KDB + (tid & 7) * 16, lq = SC_KD_BYTES + (tid >> 5) * SC_QB + (tid & 31) * 16;
        u32x4 pk[4], pq[4]; f32x4 pd = (f32x4){0.f, 0.f, 0.f, 0.f};
        __syncthreads();
#pragma unroll
        for (int i = 0; i < 4; ++i) { pk[i] = *(const u32x4*)(gk + (size_t)i * 64 * M); pq[i] = *(const u32x4*)(gq + (size_t)i * 16 * P1_LD); }
        if (tid < 64) pd = *(const f32x4*)gd;
#pragma unroll
        for (int i = 0; i < 4; ++i) { *(LAS u32x4*)(lds + lk + i * 64 * SC_KDB) = pk[i]; *(LAS u32x4*)(lds + lq + i * 16 * SC_QB) = pq[i]; }
        if (tid < 64) *(LAS f32x4*)(lds + SC_DEC_OFF + tid * 16) = pd;
        __syncthreads();
        f32x4 S[4];
#pragma unroll
        for (int i = 0; i < 4; ++i) S[i] = (f32x4){0.f, 0.f, 0.f, 0.f};
        const bf16_t* vtrow = VT + (size_t)(h * 512 + v0 + fr) * M + b * T + 8 * fq;
        bf16x8 nv0 = *(const bf16x8*)vtrow, nv1 = *(const bf16x8*)(vtrow + 32);
        const LAS unsigned char* kdb = lds + (64 * kq + fr) * SC_KDB + 16 * fq;
        const LAS unsigned char* decl = lds + SC_DEC_OFF + 256 * kq + 16 * fq;
        const LAS unsigned char* qb = lds + SC_KD_BYTES + fr * SC_QB + 128 * kq + 8 * fq;
        LAS unsigned char* pw = lds + SC_PART + wave * 4096 + lane * 16;
        const LAS unsigned char* pr = lds + SC_PART + vt * 4096 + kq * 1024 + lane * 16;
        for (int c = 0; c < 64; ++c) {
            const int tokc = c * 64;
            const bf16x8 vf0 = nv0, vf1 = nv1;
            if (c + 1 < 64) {
#pragma unroll
                for (int i = 0; i < 4; ++i) { pk[i] = *(const u32x4*)(gk + (size_t)i * 64 * M + tokc + 64); pq[i] = *(const u32x4*)(gq + (size_t)i * 16 * P1_LD + (size_t)(tokc + 64) * P1_LD); }
                nv0 = *(const bf16x8*)(vtrow + tokc + 64); nv1 = *(const bf16x8*)(vtrow + tokc + 96); if (tid < 64) pd = *(const f32x4*)(gd + (size_t)(c + 1) * 1024);
            }
#pragma unroll
            for (int j = 0; j < 4; ++j) {
                const f32x4 d = *(const LAS f32x4*)(decl + 64 * j);
                const bf16x8 a0 = *(const LAS bf16x8*)(kdb + j * 16 * SC_KDB), a1 = *(const LAS bf16x8*)(kdb + j * 16 * SC_KDB + 64);
                f32x4 sv = S[j] * d;
                sv = mfma16(a0, vf0, sv); sv = mfma16(a1, vf1, sv); S[j] = sv;
            }
            bf16x8 sf[2];
#pragma unroll
            for (int ks = 0; ks < 2; ++ks) { u32x4 w; w.x = pk2(S[2 * ks][0], S[2 * ks][1]); w.y = pk2(S[2 * ks][2], S[2 * ks][3]); w.z = pk2(S[2 * ks + 1][0], S[2 * ks + 1][1]); w.w = pk2(S[2 * ks + 1][2], S[2 * ks + 1][3]);
                sf[ks] = __builtin_bit_cast(bf16x8, w); }
#pragma unroll
            for (int ct = 0; ct < 4; ++ct) {
                f32x4 o = (f32x4){0.f, 0.f, 0.f, 0.f};
#pragma unroll
                for (int ks = 0; ks < 2; ++ks) {
                    const u32x2 q0 = *(const LAS u32x2*)(qb + ct * 16 * SC_QB + 64 * ks), q1 = *(const LAS u32x2*)(qb + ct * 16 * SC_QB + 64 * ks + 32);
                    u32x4 qw; qw.x = q0.x; qw.y = q0.y; qw.z = q1.x; qw.w = q1.y;
                    o = mfma16(sf[ks], __builtin_bit_cast(bf16x8, qw), o);
                }
                *(LAS f32x4*)(pw + ct * 1024) = o;
            }
            __syncthreads();
            {
                f32x4 o = *(const LAS f32x4*)pr;
#pragma unroll
                for (int k2 = 1; k2 < 4; ++k2) o = o + *(const LAS f32x4*)(pr + k2 * 8192);
                u32x2 w; w.x = pk2(o[0] * 0.0625f, o[1] * 0.0625f); w.y = pk2(o[2] * 0.0625f, o[3] * 0.0625f);
                *(u32x2*)(O + (size_t)(b * T + tokc + 16 * kq + fr) * D + h * 512 + v0 + 4 * fq) = w;
            }
            if (c + 1 < 64) {
#pragma unroll
                for (int i = 0; i < 4; ++i) { *(LAS u32x4*)(lds + lk + i * 64 * SC_KDB) = pk[i]; *(LAS u32x4*)(lds + lq + i * 16 * SC_QB) = pq[i]; }
                if (tid < 64) *(LAS f32x4*)(lds + SC_DEC_OFF + tid * 16) = pd;
            }
            __syncthreads();
        }
    }
}

__device__ __forceinline__ void gla_normgate_phase(const Params& p, const Ctx& cx, int j) {
    const int wave = cx.wave, lane = cx.lane;
    const bf16_t* P1 = (const bf16_t*)(cx.ws + WS_P); const bf16_t* O = (const bf16_t*)(cx.ws + WS_O); bf16_t* A2 = (bf16_t*)(cx.ws + WS_H);
    const float* gn = p.in[7] + (size_t)j * 512 + lane * 8;
    const f32x4 g0 = *(const f32x4*)gn, g1 = *(const f32x4*)(gn + 4);
    const int gw = cx.bid * 8 + wave, NGW = cx.G * 8;
    u32x4 no[4], ng[4];
    if (gw < M) {
#pragma unroll
        for (int h = 0; h < 4; ++h) { no[h] = *(const u32x4*)(O + (size_t)gw * D + h * 512 + lane * 8); ng[h] = *(const u32x4*)(P1 + (size_t)gw * P1_LD + P1_G + h * 512 + lane * 8); }
    }
    for (int tok = gw; tok < M; tok += NGW) {
        u32x4 ovv[4], gvv[4];
#pragma unroll
        for (int h = 0; h < 4; ++h) { ovv[h] = no[h]; gvv[h] = ng[h]; }
        if (tok + NGW < M) {
#pragma unroll
            for (int h = 0; h < 4; ++h) { no[h] = *(const u32x4*)(O + (size_t)(tok + NGW) * D + h * 512 + lane * 8); ng[h] = *(const u32x4*)(P1 + (size_t)(tok + NGW) * P1_LD + P1_G + h * 512 + lane * 8); }
        }
#pragma unroll
        for (int h = 0; h < 4; ++h) {
            const u32x4 ov = ovv[h], gv = gvv[h];
            float v[8], g[8];
#pragma unroll
            for (int i = 0; i < 4; ++i) { v[2 * i] = bflo(ov[i]); v[2 * i + 1] = bfhi(ov[i]); g[2 * i] = bflo(gv[i]); g[2 * i + 1] = bfhi(gv[i]); }
            float ss = 0.f;
#pragma unroll
            for (int i = 0; i < 8; ++i) ss += v[i] * v[i];
            ss = wave_sum(ss);
            const float r = __builtin_amdgcn_rsqf(ss * (1.0f / 512.0f) + RMS_EPS);
            float y[8];
#pragma unroll
            for (int i = 0; i < 8; ++i) { const float gg = (i < 4) ? g0[i] : g1[i - 4]; y[i] = v[i] * r * gg * (g[i] * __builtin_amdgcn_rcpf(1.0f + fexp(-g[i]))); }
            u32x4 w; w.x = pk2(y[0], y[1]); w.y = pk2(y[2], y[3]); w.z = pk2(y[4], y[5]); w.w = pk2(y[6], y[7]);
            *(u32x4*)(A2 + (size_t)tok * D + h * 512 + lane * 8) = w;
        }
    }
}

__device__ __forceinline__ void dsa_post_phase(const Params& p, const Ctx& cx, int j) {
    const int wave = cx.wave, lane = cx.lane;
    const bf16_t* P2 = (const bf16_t*)(cx.ws + WS_P); bf16_t* CN = (bf16_t*)(cx.ws + WS_CN); bf16_t* KI = (bf16_t*)(cx.ws + WS_KI); float* WI = (float*)(cx.ws + WS_WI);
    const f32x4 kvn = *(const f32x4*)(p.in[10] + (size_t)j * 256 + lane * 4);
    const float kn0 = p.in[11][(size_t)j * 128 + lane * 2], kn1 = p.in[11][(size_t)j * 128 + lane * 2 + 1];
    const int gw = cx.bid * 8 + wave, NGW = cx.G * 8;
    for (int m = gw; m < M; m += NGW) {
        const bf16_t* row = P2 + (size_t)m * P2_LD;
        const u32x2 cv = *(const u32x2*)(row + P2_C + lane * 4);
        const float c0 = bflo(cv.x), c1 = bfhi(cv.x), c2 = bflo(cv.y), c3 = bfhi(cv.y);
        float ss = wave_sum((c0 * c0 + c1 * c1) + (c2 * c2 + c3 * c3));
        float r = 1.0f / sqrtf(ss * (1.0f / 256.0f) + RMS_EPS);
        u32x2 w; w.x = pk2(c0 * r * kvn[0], c1 * r * kvn[1]); w.y = pk2(c2 * r * kvn[2], c3 * r * kvn[3]);
        *(u32x2*)(CN + (size_t)m * 256 + lane * 4) = w;
        const unsigned kv = *(const unsigned*)(row + P2_KI + lane * 2);
        const float k0 = bflo(kv), k1 = bfhi(kv);
        ss = wave_sum(k0 * k0 + k1 * k1);
        r = 1.0f / sqrtf(ss * (1.0f / 128.0f) + RMS_EPS);
        *(unsigned*)(KI + (size_t)m * 128 + lane * 2) = pk2(k0 * r * kn0, k1 * r * kn1);
        if (lane < 16) WI[(size_t)m * 16 + lane] = bf2f(row[P2_WI + lane]) * (0.25f * 0.08838834764831845f);
    }
}

__device__ __forceinline__ void dsa_index_phase(const Params& p, const Ctx& cx, LAS unsigned char* lds) {
    const int wave = cx.wave, lane = cx.lane;
    const bf16_t* P2 = (const bf16_t*)(cx.ws + WS_P); const bf16_t* KI = (const bf16_t*)(cx.ws + WS_KI); const float* WI = (const float*)(cx.ws + WS_WI); int* IDX = (int*)(cx.ws + WS_IDX);
    const int G = cx.G;
    const int pair = wave >> 1, kh = wave & 1, rho = lane & 31, hA = lane >> 5;
    for (int k = 0;; ++k) {
        const int it = cx.bid + k * G; if (it >= 2048) break;
        int b, pos; if (G == 256) { b = k >> 1; pos = (k & 1) ? 511 - cx.bid : cx.bid; } else { b = it >> 9; pos = it & 511; }
        const int q0 = pos * 8, nch = (q0 >> 6) + 1, ntile = 2 * nch;
        {
            const int qA = q0 + 2 * pair + ((rho >> 2) & 1), headA = (rho & 3) + 4 * (rho >> 3);
            const bf16_t* qip = P2 + (size_t)(b * T + qA) * P2_LD + P2_QI + headA * 128 + 8 * hA;
            bf16x8 af[8];
#pragma unroll
            for (int s = 0; s < 8; ++s) af[s] = *(const bf16x8*)(qip + 16 * s);
            const float* wp = WI + (size_t)(b * T + q0 + 2 * pair + hA) * 16;
            f32x4 w4[4];
#pragma unroll
            for (int i = 0; i < 4; ++i) w4[i] = *(const f32x4*)(wp + 4 * i);
            LAS float* sc = (LAS float*)lds + (2 * pair + hA) * 4096;
            LAS unsigned char* stg = lds + 131072;
            const char* kub = (const char*)(KI + (size_t)(b * T) * 128);
            const unsigned kvo = (unsigned)(((cx.tid >> 4) * 128 + (cx.tid & 15) * 8) * 2);
#define KLD(TILE, HALF_) (*(const u32x4*)(kub + (size_t)(TILE) * 16384 + (size_t)(HALF_) * 8192 + kvo))
            const int sto = (cx.tid >> 4) * 272 + (cx.tid & 15) * 16;
            __builtin_amdgcn_s_waitcnt(0);
            u32x4 rA0 = KLD(0, 0), rA1 = KLD(0, 1), rB0 = rA0, rB1 = rA1;
            if (nch > 1) { rB0 = KLD(1, 0); rB1 = KLD(1, 1); }
            const LAS unsigned char* brd = stg + (kh * 32 + rho) * 272 + 16 * hA;
#define IDX_TILE(R0, R1, TILE) do { \
                __syncthreads(); \
                *(LAS u32x4*)(stg + sto) = R0; *(LAS u32x4*)(stg + sto + 32 * 272) = R1; \
                __syncthreads(); \
                if ((TILE) + 2 < nch) { R0 = KLD((TILE) + 2, 0); R1 = KLD((TILE) + 2, 1); } \
                bf16x8 bfr[8]; \
                _Pragma("unroll") for (int s = 0; s < 8; ++s) bfr[s] = *(const LAS bf16x8*)(brd + 32 * s); \
                f32x16 acc, acc2; \
                _Pragma("unroll") for (int i = 0; i < 16; ++i) { acc[i] = 0.f; acc2[i] = 0.f; } \
                _Pragma("unroll") for (int s = 0; s < 4; ++s) { acc = mfma32(af[2 * s], bfr[2 * s], acc); acc2 = mfma32(af[2 * s + 1], bfr[2 * s + 1], acc2); } \
                float v = 0.f, v2 = 0.f; \
                _Pragma("unroll") for (int i = 0; i < 16; i += 2) { v += w4[i >> 2][i & 3] * fmaxf(acc[i] + acc2[i], 0.f); v2 += w4[(i + 1) >> 2][(i + 1) & 3] * fmaxf(acc[i + 1] + acc2[i + 1], 0.f); } \
                v += v2; \
                sc[(TILE) * 64 + kh * 32 + rho] = v; } while (0)
            for (int tile = 0; tile < nch; tile += 2) {
                IDX_TILE(rA0, rA1, tile);
                if (tile + 1 < nch) IDX_TILE(rB0, rB1, tile + 1);
            }
#undef IDX_TILE
#undef KLD
        }
        __syncthreads();
        {
            const LAS unsigned* su = (const LAS unsigned*)lds + wave * 4096 + lane;
            unsigned u[64];
#pragma unroll
            for (int jj = 0; jj < 64; ++jj) { unsigned x = 0u; if (jj < nch) { const unsigned bits = su[jj * 64]; x = (bits & 0x80000000u) ? ~bits : (bits | 0x80000000u); } u[jj] = x; }
            int* ip = IDX + (size_t)(b * T + q0 + wave) * 256;
            if (nch <= 4) {
#pragma unroll
                for (int jj = 0; jj < 4; ++jj) ip[jj * 64 + lane] = (jj < nch) ? jj * 64 + lane : -1;
            } else {
                unsigned Tt = 0u;
                for (int bit = 31; bit >= 0; --bit) {
                    const unsigned cand = Tt | (1u << bit); int cnt = 0;
#pragma unroll
                    for (int g8 = 0; g8 < 8; ++g8) { if (g8 * 8 < nch) {
#pragma unroll
                        for (int jj = g8 * 8; jj < g8 * 8 + 8; ++jj) cnt += __builtin_popcountll(__ballot(u[jj] >= cand)); } }
                    if (cnt >= 256) Tt = cand;
                    if (cnt == 256) break;
                }
                int basep = 0;
#pragma unroll
                for (int jj = 0; jj < 64; ++jj) { if (jj >= nch) continue; const bool sel = u[jj] > Tt; const unsigned long long mk = __ballot(sel);
                    const int ps = basep + (int)__builtin_amdgcn_mbcnt_hi((unsigned)(mk >> 32), __builtin_amdgcn_mbcnt_lo((unsigned)mk, 0u));
                    if (sel) ip[ps] = jj * 64 + lane; basep += __builtin_popcountll(mk); }
#pragma unroll
                for (int jj = 0; jj < 64; ++jj) { if (jj >= nch) continue; const bool sel = u[jj] == Tt; const unsigned long long mk = __ballot(sel);
                    const int ps = basep + (int)__builtin_amdgcn_mbcnt_hi((unsigned)(mk >> 32), __builtin_amdgcn_mbcnt_lo((unsigned)mk, 0u));
                    if (sel && ps < 256) ip[ps] = jj * 64 + lane; basep += __builtin_popcountll(mk); }
            }
        }
        __syncthreads();
    }
}

constexpr int AT_ROWB = 528, AT_WAVEB = 32 * AT_ROWB, AT_BIAS = 8 * AT_WAVEB;
__device__ __forceinline__ s16x4 ld_tr(const LAS unsigned char* ptr) { return __builtin_bit_cast(s16x4, __builtin_amdgcn_ds_read_tr16_b64_v4i16((LAS s16x4*)ptr)); }
__device__ __forceinline__ int att_tok(const Ctx& cx, int k, int wloc) {
    if (cx.G == 256) return (k < 8) ? ((cx.bid & 7) >> 1) * T + k * 512 + wloc : -1;
    const int tok = cx.bid * 8 + cx.wave + k * cx.G * 8; return tok < M ? tok : -1;
}
#define ATT_GATHER(IR, SBLO, BB) do { const bf16_t* cb_ = CN + (size_t)(BB) * T * 256 + (lane & 31) * 8; _Pragma("unroll") for (int i_ = 0; i_ < 16; ++i_) { const int kidx_ = __shfl((IR), 32 * (SBLO) + 2 * i_ + (lane >> 5)); const unsigned kk_ = kidx_ < 0 ? 0u : (unsigned)kidx_; \
        g[i_] = *(const u32x4*)(cb_ + kk_ * 256u); if ((i_ & 3) == 3) asm volatile("" ::: "memory"); } } while (0)
__device__ __forceinline__ void dsa_attn_phase(const Params& p, const Ctx& cx, LAS unsigned char* lds) {
    const int wave = cx.wave, lane = cx.lane;
    const bf16_t* P2 = (const bf16_t*)(cx.ws + WS_P); const bf16_t* CN = (const bf16_t*)(cx.ws + WS_CN); const int* IDX = (const int*)(cx.ws + WS_IDX); bf16_t* OB = (bf16_t*)(cx.ws + WS_OB);
    LAS float* lb = (LAS float*)(lds + AT_BIAS);
    for (int e_ = cx.tid; e_ < 256 * 16; e_ += 512) { const int rel = (e_ >> 4) - 128, hd = e_ & 15, n = rel < 0 ? -rel : rel;
        const int large = 8 + (n >= 12) + (n >= 16) + (n >= 23) + (n >= 32) + (n >= 46) + (n >= 64) + (n >= 91);
        const int bk = ((rel > 0) ? 16 : 0) + ((n < 8) ? n : large);
        lb[e_] = p.in[14][bk * 16 + hd]; }
    __syncthreads();
    LAS unsigned char* wl = lds + wave * AT_WAVEB;
    const int fr = lane & 15, fq = lane >> 4;
    const int wloc = ((cx.bid & 1) * 32 + (cx.bid >> 3)) * 8 + wave;
    int tok = att_tok(cx, 0, wloc);
    int ir0 = 0, ir1 = 0, ir2 = 0, ir3 = 0;
    u32x4 g[16];
    if (tok >= 0) { const int* ip = IDX + (size_t)tok * 256 + lane; ir0 = ip[0]; ir1 = ip[64]; ir2 = ip[128]; ir3 = ip[192]; }
    for (int k = 0; tok >= 0; ++k) {
        const int b = tok >> 12, t = tok & (T - 1);
        const int ntok = att_tok(cx, k + 1, wloc);
        int nr0 = 0, nr1 = 0, nr2 = 0, nr3 = 0;
        if (ntok >= 0) { const int* ip = IDX + (size_t)ntok * 256 + lane; nr0 = ip[0]; nr1 = ip[64]; nr2 = ip[128]; nr3 = ip[192]; }
        const bf16_t* qp = P2 + (size_t)tok * P2_LD + P2_Q + fr * 256 + 8 * fq;
        float m_run = -INFINITY, l_run = 0.f;
        f32x4 oacc[16];
#pragma unroll
        for (int i = 0; i < 16; ++i) oacc[i] = (f32x4){0.f, 0.f, 0.f, 0.f};
        for (int sb = 0; sb < 8; ++sb) {
            const int h2 = sb >> 1, irc = (h2 == 0) ? ir0 : (h2 == 1) ? ir1 : (h2 == 2) ? ir2 : ir3;
            ATT_GATHER(irc, sb & 1, b);
#pragma unroll
            for (int i = 0; i < 16; ++i) *(LAS u32x4*)(wl + (2 * i + (lane >> 5)) * AT_ROWB + (lane & 31) * 16) = g[i];
            int kx[8];
#pragma unroll
            for (int e = 0; e < 8; ++e) kx[e] = __shfl(irc, 32 * (sb & 1) + 16 * (e >> 2) + 4 * fq + (e & 3));
            bf16x8 qf[8];
            { size_t qo_ = 0; asm volatile("" : "+s"(qo_));
#pragma unroll
              for (int s = 0; s < 8; ++s) qf[s] = *(const bf16x8*)(qp + qo_ + 32 * s); }
            asm volatile("s_waitcnt lgkmcnt(0)" ::: "memory");
            f32x4 sacc[2];
#pragma unroll
            for (int kt2 = 0; kt2 < 2; ++kt2) { f32x4 a = (f32x4){0.f, 0.f, 0.f, 0.f};
#pragma unroll
                for (int s = 0; s < 8; ++s) { const bf16x8 cf = *(const LAS bf16x8*)(wl + (16 * kt2 + fr) * AT_ROWB + (32 * s + 8 * fq) * 2); a = mfma16(cf, qf[s], a); if ((s & 3) == 3) asm volatile("" ::: "memory"); }
                sacc[kt2] = a; }
            float lg[8];
#pragma unroll
            for (int e = 0; e < 8; ++e) { const int kidx = kx[e]; const float a = ((e < 4) ? sacc[0][e & 3] : sacc[1][e & 3]) * 0.0625f;
                int rel = kidx - t; rel = rel < -128 ? -128 : (rel > 127 ? 127 : rel);
                const float bias = lb[(rel + 128) * 16 + fr];
                lg[e] = (kidx < 0) ? -INFINITY : a + bias; }
            float bm = fmaxf(fmaxf(fmaxf(lg[0], lg[1]), fmaxf(lg[2], lg[3])), fmaxf(fmaxf(lg[4], lg[5]), fmaxf(lg[6], lg[7])));
            bm = fmaxf(bm, __shfl_xor(bm, 16)); bm = fmaxf(bm, __shfl_xor(bm, 32));
            const float m_new = fmaxf(m_run, bm), scale = __expf(m_run - m_new);
            float pe[8], psum = 0.f;
#pragma unroll
            for (int e = 0; e < 8; ++e) { pe[e] = __expf(lg[e] - m_new); psum += pe[e]; }
            l_run = l_run * scale + psum; m_run = m_new;
#pragma unroll
            for (int i = 0; i < 16; ++i) oacc[i] = oacc[i] * scale;
            u32x4 pw; pw.x = pk2(pe[0], pe[1]); pw.y = pk2(pe[2], pe[3]); pw.z = pk2(pe[4], pe[5]); pw.w = pk2(pe[6], pe[7]);
            const bf16x8 pf = __builtin_bit_cast(bf16x8, pw);
            const LAS unsigned char* tb = wl + (4 * fq + ((lane & 15) >> 2)) * AT_ROWB + 8 * (lane & 3);
#pragma unroll
            for (int lt = 0; lt < 16; ++lt) {
                const s16x4 t0 = ld_tr(tb + 32 * lt), t1 = ld_tr(tb + 16 * AT_ROWB + 32 * lt);
                bf16x8 cf; cf[0] = t0[0]; cf[1] = t0[1]; cf[2] = t0[2]; cf[3] = t0[3]; cf[4] = t1[0]; cf[5] = t1[1]; cf[6] = t1[2]; cf[7] = t1[3];
                oacc[lt] = mfma16(cf, pf, oacc[lt]);
                if ((lt & 3) == 3) asm volatile("" ::: "memory");
            }
            asm volatile("s_waitcnt lgkmcnt(0)" ::: "memory");
        }
        float lt_ = l_run + __shfl_xor(l_run, 16); lt_ += __shfl_xor(lt_, 32);
        const float inv = 1.0f / lt_;
        bf16_t* op = OB + (size_t)tok * 4096 + fr * 256 + 4 * fq;
#pragma unroll
        for (int lt = 0; lt < 16; ++lt) { u32x2 w; w.x = pk2(oacc[lt][0] * inv, oacc[lt][1] * inv); w.y = pk2(oacc[lt][2] * inv, oacc[lt][3] * inv); *(u32x2*)(op + 16 * lt) = w; }
        tok = ntok; ir0 = nr0; ir1 = nr1; ir2 = nr2; ir3 = nr3;
    }
    __syncthreads();
}

#define XB_TMO      128
#define XB_XCNT(j)  (256  + 64 * (j))
#define XB_XSUB(j)  (1280 + 64 * (j))
#define XB_XGEN(j)  (2304 + 64 * (j))
#define XB_TOP      3328
#define XB_TOPGEN   3392
#define XCD_BAR_WORDS 3456
#define XB_SPIN_CAP (1u << 22)
__device__ __forceinline__ unsigned xb_ld(unsigned* p)              { return __hip_atomic_load(p, __ATOMIC_RELAXED, __HIP_MEMORY_SCOPE_AGENT); }
__device__ __forceinline__ unsigned xb_add(unsigned* p, unsigned v) { return __hip_atomic_fetch_add(p, v, __ATOMIC_RELAXED, __HIP_MEMORY_SCOPE_AGENT); }
__device__ __forceinline__ unsigned xb_xcc_id() { return (unsigned)__builtin_amdgcn_s_getreg((3 << 11) | 20) & 0xFu; }
#define XB_SPIN(cond, bar) do { unsigned _sp = 0; while (cond) { __builtin_amdgcn_s_sleep(1); \
    if ((++_sp & 255u) == 0u) { if (xb_ld(&(bar)[XB_TMO])) break; if (_sp > XB_SPIN_CAP) { atomicAdd(&(bar)[XB_TMO], 1u); break; } } } } while (0)
struct XcdBarrier { unsigned* bar; unsigned x; volatile LAS unsigned* st; };
__device__ __forceinline__ XcdBarrier xcd_barrier_post(unsigned* bar, volatile LAS unsigned* st) {
    XcdBarrier b; b.bar = bar; b.x = xb_xcc_id(); b.st = st;
    if (threadIdx.x == 0) (void)xb_add(&bar[XB_XCNT(b.x)], 1u);
    return b;
}
__device__ __forceinline__ void xcd_barrier_complete(unsigned* bar, unsigned x, unsigned& nloc, unsigned& nx) {
    const unsigned G = gridDim.x * gridDim.y * gridDim.z;
    unsigned sum, cnt, mine, sp = 0u;
    for (;;) {
        sum = 0u; cnt = 0u; mine = 0u;
#pragma unroll
        for (unsigned j = 0; j < 16; ++j) { const unsigned c = xb_ld(&bar[XB_XCNT(j)]); sum += c; cnt += (c > 0u) ? 1u : 0u; mine = (j == x) ? c : mine; }
        if (sum == G) break;
        __builtin_amdgcn_s_sleep(1);
        if ((++sp & 255u) == 0u) { if (xb_ld(&bar[XB_TMO])) break; if (sp > XB_SPIN_CAP) { atomicAdd(&bar[XB_TMO], 1u); break; } }
    }
    nloc = mine > 0u ? mine : 1u; nx = cnt > 0u ? cnt : 1u;
}
__device__ __forceinline__ void xcd_barrier(const XcdBarrier& b) {
    asm volatile("s_waitcnt vmcnt(0)" ::: "memory");
    __syncthreads();
    if (threadIdx.x == 0) {
        unsigned* bar = b.bar;
        __builtin_amdgcn_s_waitcnt(0);
        unsigned nloc = b.st[0], nx = b.st[1];
        if (nloc == 0u) { xcd_barrier_complete(bar, b.x, nloc, nx); b.st[0] = nloc; b.st[1] = nx; }
        const unsigned old = xb_add(&bar[XB_XSUB(b.x)], 1u);
        const unsigned gen = old / nloc;
        if (old + 1u == (gen + 1u) * nloc) {
            __builtin_amdgcn_fence(__ATOMIC_RELEASE, "agent");
            asm volatile("s_waitcnt vmcnt(0)" ::: "memory");
            const unsigned og = xb_add(&bar[XB_TOP], 1u);
            const unsigned tg = og / nx;
            if (og + 1u == (tg + 1u) * nx) xb_add(&bar[XB_TOPGEN], 1u);
            else XB_SPIN(xb_ld(&bar[XB_TOPGEN]) == tg, bar);
            __builtin_amdgcn_fence(__ATOMIC_ACQUIRE, "agent");
            xb_add(&bar[XB_XGEN(b.x)], 1u);
            asm volatile("s_waitcnt vmcnt(0)" ::: "memory");
        } else {
            XB_SPIN(xb_ld(&bar[XB_XGEN(b.x)]) == gen, bar);
            __builtin_amdgcn_fence(__ATOMIC_ACQUIRE, "agent");
            asm volatile("s_waitcnt vmcnt(0)" ::: "memory");
        }
    }
    __syncthreads();
}

constexpr int N_PHASES = 42;
__host__ __device__ inline bool phase_is_nop(int ph) { if (ph == 0 || ph == 41) return false; const int L = (ph - 1) / 10, s = (ph - 1) % 10; return (!(L & 1)) && s == 6; }

__host__ __device__ inline int phase_kind(int ph) {
    if (ph == 0) return 0; if (ph == 41) return 1;
    const int L = (ph - 1) / 10, s = (ph - 1) % 10; const bool gla = !(L & 1);
    if (s == 0 || s == 7) return 1; if (s == 1 || (!gla && s == 5)) return 2; if ((gla && s == 5) || (!gla && s == 6) || s == 9) return 3; if (s == 8) return 4;
    if (gla) return 3 + s; return 6 + s;
}
__global__ void __launch_bounds__(512, 2) trunk_fwd(Params p) {
    extern __shared__ __attribute__((aligned(16))) unsigned char smem[];
    LAS unsigned char* lds = (LAS unsigned char*)smem;
    volatile LAS unsigned* bst = (volatile LAS unsigned*)(lds + LDS_CTL);
    if (threadIdx.x < 64) bst[threadIdx.x] = 0u;
    __syncthreads();
    XcdBarrier gbar = xcd_barrier_post((unsigned*)p.ws, bst);
    if (p.ph_lo > 1000) cg::this_grid().sync();
    for (int ph = p.ph_lo, rep_ = 0; ph < p.ph_hi;) {
        if (phase_is_nop(ph)) { ++ph; continue; }
        Ctx cx;
        { int t_ = threadIdx.x; asm volatile("" : "+v"(t_)); int b_ = blockIdx.x; asm volatile("" : "+s"(b_)); int g_ = gridDim.x; asm volatile("" : "+s"(g_));
          size_t z_ = 0; asm volatile("" : "+s"(z_)); unsigned char* w_ = p.ws + z_;
          cx.tid = t_; cx.lane = t_ & 63; cx.wave = __builtin_amdgcn_readfirstlane(t_ >> 6); cx.bid = b_; cx.G = g_; cx.ws = w_; }
        unsigned char* ws = cx.ws;
        bf16_t* Hb = (bf16_t*)(ws + WS_H); bf16_t* Pb = (bf16_t*)(ws + WS_P);
        if (ph == 0) { if (PHON(0)) prologue_phase(p, cx, lds); }
        else if (ph == 41) { if (PHON(1)) rms_phase<true, true>(ws + WS_XR, p.in[3], p.out, cx); }
        else {
            const int L = (ph - 1) / 10, s = (ph - 1) % 10, j = L >> 1; const bool gla = !(L & 1);
            unsigned char* wg = ws + WS_W + j * GLA_STRIDE; unsigned char* wd = ws + DSA_BASE + j * DSA_STRIDE; unsigned char* wf = ws + FFN_BASE + L * FFN_STRIDE;
            if (s == 0) { if (PHON(1)) { if (L == 0) rms_phase<false, false>(p.in[0], p.in[1], Hb, cx); else rms_phase<true, false>(ws + WS_XR, p.in[1] + (size_t)L * D, Hb, cx); } }
            else if (s == 7) { if (PHON(1)) rms_phase<true, false>(ws + WS_XR, p.in[2] + (size_t)L * D, Hb, cx); }
            else if (s == 1 || (!gla && s == 5)) {
                const int ng = (gla && s == 1) ? 2 : 1;
                for (int gi = 0; gi < ng; ++gi) {
                    pg8::Gemm g; pg8::EpiStore E;
                    if (gla) {
                        if (gi == 0) { g = pg8::Gemm{Hb, (const bf16_t*)(wg + GLA_WINA), M, 4096, D, D, D, 0}; E = pg8::EpiStore{Pb, P1_LD}; }
                        else { g = pg8::Gemm{(const bf16_t*)(wg + GLA_WV), Hb, D, M, D, D, D, 0}; E = pg8::EpiStore{(bf16_t*)(ws + WS_VT), M}; }
                    } else if (s == 1) { g = pg8::Gemm{Hb, (const bf16_t*)(wd + DSA_WIN), M, P2_LD, D, D, D, 0}; E = pg8::EpiStore{Pb, P2_LD}; }
                    else { g = pg8::Gemm{(const bf16_t*)(ws + WS_OB), (const bf16_t*)(wd + DSA_WUV), M, D, 512, 4096, 512, 512}; E = pg8::EpiStore{Hb, D}; }
                    pg8::StaticOrder S; S.init(g.M, g.N, cx.G, cx.bid);
                    if (PHON(2)) pg8::gemm_phase(lds, g, S, E, cx.tid);
                }
            } else if ((gla && s == 5) || (!gla && s == 6) || s == 9) {
                pg8::Gemm g;
                if (s == 9) g = pg8::Gemm{Pb, (const bf16_t*)(wf + FFN_W2), M, D, FF, FF, FF, 0};
                else g = pg8::Gemm{Hb, (const bf16_t*)(gla ? wg + GLA_WOUT : wd + DSA_WOUT), M, D, D, D, D, 0};
                pg8::EpiResid E{(L == 0 && s < 6) ? p.in[0] : nullptr, (bf16_t*)(ws + WS_XR)};
                pg8::StaticOrder S; S.init(g.M, g.N, cx.G, cx.bid);
                if (PHON(3)) pg8::gemm_phase(lds, g, S, E, cx.tid);
            } else if (s == 8) {
                pg8::Gemm g{Hb, (const bf16_t*)(wf + FFN_W13), M, 2 * FF, D, D, D, 0};
                pg8::EpiSwiglu E{Pb};
                pg8::StaticOrder S; S.init(g.M, g.N, cx.G, cx.bid);
                if (PHON(4)) pg8::gemm_phase(lds, g, S, E, cx.tid);
            } else if (gla) {
                if (s == 2) { if (PHON(5)) gla_gate_phase(p, cx, j, lds); }
                else if (s == 3) { if (PHON(6)) gla_scan_phase(p, cx, lds); }
                else if (s == 4) { if (PHON(7)) gla_normgate_phase(p, cx, j); }
            } else {
                if (s == 2) { if (PHON(8)) dsa_post_phase(p, cx, j); }
                else if (s == 3) { if (PHON(9)) dsa_index_phase(p, cx, lds); }
                else if (s == 4) { if (PHON(10)) dsa_attn_phase(p, cx, lds); }
            }
        }
        if (ph + 1 < p.ph_hi) { xcd_barrier(gbar); if ((REP_MASK >> 11) & 1) xcd_barrier(gbar); }
        if (REP_MASK && rep_ == 0 && phase_kind(ph) != 3 && ((REP_MASK >> phase_kind(ph)) & 1)) rep_ = 1; else { rep_ = 0; ++ph; }
    }
}

extern "C" void kernel_launch(void* const* d_in, const int* in_sizes, int n_in, void* d_out, int out_size, void* d_ws, size_t ws_size, hipStream_t stream) {
    static int grid = 0;
    if (!grid) {
        if (n_in != 18 || out_size != M * D || ws_size < WS_END) { fprintf(stderr, "kernel_launch: unexpected shapes (n_in %d out %d ws %zu)\n", n_in, out_size, ws_size); grid = -1; return; }
        int dev = 0, cus = 0, per_cu = 0;
        hipGetDevice(&dev); hipDeviceGetAttribute(&cus, hipDeviceAttributeMultiprocessorCount, dev);
        if (hipFuncSetAttribute((const void*)trunk_fwd, hipFuncAttributeMaxDynamicSharedMemorySize, LDS_BYTES) != hipSuccess) { fprintf(stderr, "kernel_launch: hipFuncSetAttribute failed\n"); grid = -1; return; }
        hipOccupancyMaxActiveBlocksPerMultiprocessor(&per_cu, (const void*)trunk_fwd, 512, LDS_BYTES);
        if (per_cu < 1) per_cu = 1;
        grid = cus * per_cu;
        fprintf(stderr, "kernel_launch: grid %d (cus %d x %d)\n", grid, cus, per_cu);
    }
    if (grid < 0) return;
    if (hipMemsetAsync(d_ws, 0, XCD_BAR_WORDS * 4, stream) != hipSuccess) { fprintf(stderr, "kernel_launch: memset failed\n"); return; }
    Params p{};
    for (int i = 0; i < 18; ++i) p.in[i] = (const float*)d_in[i];
    p.out = (float*)d_out; p.ws = (unsigned char*)d_ws;
#if MK_MULTI
    for (int ph = 0; ph < N_PHASES; ++ph) {
        if (phase_is_nop(ph)) continue;
        p.ph_lo = ph; p.ph_hi = ph + 1;
        hipLaunchKernelGGL(trunk_fwd, dim3(grid), dim3(512), LDS_BYTES, stream, p);
    }
#else
    p.ph_lo = 0; p.ph_hi = N_PHASES;
    void* args[] = {&p};
    hipError_t e = hipLaunchCooperativeKernel((const void*)trunk_fwd, dim3(grid), dim3(512), args, LDS_BYTES, stream);
    if (e != hipSuccess) fprintf(stderr, "cooperative launch failed: %s (grid %d)\n", hipGetErrorString(e), grid);
#endif
}
```

```cpp
#include <hip/hip_runtime.h>
#include <hip/hip_cooperative_groups.h>
#include <cstdio>
#include <cstdint>
namespace cg = cooperative_groups;

#ifndef PH_MASK
#define PH_MASK 0xFFFF
#endif
#define PHON(k) ((PH_MASK >> (k)) & 1)
#ifndef REP_MASK
#define REP_MASK 0
#endif
#ifndef MK_MULTI
#define MK_MULTI 0
#endif

#define LAS __attribute__((address_space(3)))
typedef unsigned short bf16_t;
typedef short bf16x8 __attribute__((ext_vector_type(8)));
typedef short s16x4 __attribute__((ext_vector_type(4)));
typedef float f32x4 __attribute__((ext_vector_type(4)));
typedef float f32x16 __attribute__((ext_vector_type(16)));
typedef unsigned u32x4 __attribute__((ext_vector_type(4)));
typedef unsigned u32x2 __attribute__((ext_vector_type(2)));
typedef int i32x4 __attribute__((ext_vector_type(4)));

constexpr int NB = 4, T = 4096, M = NB * T, D = 2048, FF = 5632;
constexpr int P1_LD = 4352, P1_Q = 0, P1_K = 1024, P1_G = 2048, P1_A = 4096;
constexpr int P2_LD = 6656, P2_Q = 0, P2_C = 4096, P2_QI = 4352, P2_KI = 6400, P2_WI = 6528;
constexpr float RMS_EPS = 1e-6f;

constexpr size_t MiB = 1u << 20;
constexpr size_t WS_W = 1 * MiB;
constexpr size_t GLA_STRIDE = 33 * MiB, GLA_WINA = 0, GLA_WV = 17 * MiB, GLA_WOUT = 25 * MiB;
constexpr size_t DSA_BASE = WS_W + 66 * MiB, DSA_STRIDE = 36 * MiB, DSA_WIN = 0, DSA_WUV = 26 * MiB, DSA_WOUT = 28 * MiB;
constexpr size_t FFN_BASE = WS_W + 138 * MiB, FFN_STRIDE = 66 * MiB, FFN_W13 = 0, FFN_W2 = 44 * MiB;
constexpr size_t WS_H = 403 * MiB, WS_P = 467 * MiB, WS_VT = 603 * MiB, WS_X2 = 675 * MiB;
constexpr size_t WS_KDT = WS_X2, WS_DEC = WS_X2 + 32 * MiB, WS_O = WS_X2 + 33 * MiB;
constexpr size_t WS_CN = WS_X2, WS_KI = WS_X2 + 8 * MiB, WS_WI = WS_X2 + 12 * MiB, WS_IDX = WS_X2 + 13 * MiB, WS_OB = WS_X2 + 29 * MiB;
constexpr size_t WS_XR = 832 * MiB;
constexpr size_t WS_RSTD = 896 * MiB, WS_SS = 897 * MiB;
constexpr size_t WS_END = 900 * MiB;
constexpr int LDS_BYTES = 163840, LDS_CTL = 163584;

struct Params { const float* in[18]; float* out; unsigned char* ws; int ph_lo, ph_hi; };
struct Ctx { int tid, lane, wave, bid, G; unsigned char* ws; };

__device__ __forceinline__ float bf2f(bf16_t u) { return __builtin_bit_cast(float, (unsigned)u << 16); }
__device__ __forceinline__ float bflo(unsigned u) { return __builtin_bit_cast(float, u << 16); }
__device__ __forceinline__ float bfhi(unsigned u) { return __builtin_bit_cast(float, u & 0xffff0000u); }
typedef __bf16 bf16x2_t __attribute__((ext_vector_type(2)));
typedef float f32x2_t __attribute__((ext_vector_type(2)));
__device__ __forceinline__ unsigned pk2(float lo, float hi) { const f32x2_t v = {lo, hi}; const bf16x2_t b = __builtin_convertvector(v, bf16x2_t); return __builtin_bit_cast(unsigned, b); }
__device__ __forceinline__ float wave_sum(float v) {
#pragma unroll
    for (int o = 1; o < 64; o <<= 1) v += __shfl_xor(v, o);
    return v;
}
__device__ __forceinline__ f32x4 mfma16(bf16x8 a, bf16x8 b, f32x4 c) { return __builtin_amdgcn_mfma_f32_16x16x32_bf16(a, b, c, 0, 0, 0); }
__device__ __forceinline__ f32x16 mfma32(bf16x8 a, bf16x8 b, f32x16 c) { return __builtin_amdgcn_mfma_f32_32x32x16_bf16(a, b, c, 0, 0, 0); }

namespace pg8 {
constexpr int BM = 256, BK = 64, HALF = 128, HTB = HALF * BK * 2, STAGE_BYTES = 8 * HTB, NXCD = 8, WGM = 8;
__host__ __device__ __forceinline__ int lds_byte(int r, int c) { const int st = (r >> 4) * 2 + (c >> 5), rr = r & 15, cc = c & 31, ob = rr * 64 + cc * 2; return st * 1024 + (ob ^ (((ob >> 9) & 1) << 5)); }
__host__ __device__ __forceinline__ void stage_rc(int b, int& R, int& C) { const int st = b / 1024, sb = b % 1024, swz = sb ^ (((sb >> 9) & 1) << 5); R = (st >> 1) * 16 + swz / 64; C = (st & 1) * 32 + (swz % 64) / 2; }
__host__ __device__ __forceinline__ int perm32(int rho) { const int n = rho >> 4, i = rho & 15; return 8 * (i >> 2) + 4 * n + (i & 3); }

struct Unit { int pm, pn; };
struct Gemm { const bf16_t* A; const bf16_t* Bt; int M, N, K, lda, ldb, apn; };

struct StaticOrder {
    int nM, nN, nwg, G, c;
    __device__ void init(int M_, int N_, int G_, int c_) { nM = M_ / BM; nN = N_ / BM; nwg = nM * nN; G = G_; c = c_; }
    __device__ bool next(int i, Unit& u) const {
        const long L = (long)i * G + c; if (L >= nwg) return false;
        int wgid = (int)L; { const int q = nwg / NXCD, r = nwg % NXCD, xcd = wgid % NXCD, off = wgid / NXCD; wgid = (xcd < r ? xcd * (q + 1) : r * (q + 1) + (xcd - r) * q) + off; }
        const int nig = WGM * nN, gid = wgid / nig, fm = gid * WGM, gsz = (nM - fm) < WGM ? (nM - fm) : WGM;
        u.pm = fm + ((wgid % nig) % gsz); u.pn = (wgid % nig) / gsz; return true;
    }
};

struct EpiStore {
    bf16_t* O; int ldc; const float* rstd;
    __device__ __forceinline__ void operator()(const f32x4 (&acc)[2][2][4][2], const Unit& u, int wr, int wc, int fr, int fq) const {
        const int row0 = u.pm * BM + wr * 64 + fr, col0 = u.pn * BM + wc * 32 + 8 * fq;
        float rs[2][4];
#pragma unroll
        for (int ai = 0; ai < 2; ++ai)
#pragma unroll
            for (int m = 0; m < 4; ++m) rs[ai][m] = rstd ? rstd[row0 + ai * HALF + m * 16] : 1.0f;
#pragma unroll
        for (int ai = 0; ai < 2; ++ai)
#pragma unroll
            for (int m = 0; m < 4; ++m) { bf16_t* rowp = O + (size_t)(row0 + ai * HALF + m * 16) * ldc + col0;
#pragma unroll
                for (int bj = 0; bj < 2; ++bj) { const f32x4 v0 = acc[ai][bj][m][0] * rs[ai][m], v1 = acc[ai][bj][m][1] * rs[ai][m];
                    u32x4 w; w.x = pk2(v0[0], v0[1]); w.y = pk2(v0[2], v0[3]); w.z = pk2(v1[0], v1[1]); w.w = pk2(v1[2], v1[3]);
                    *(u32x4*)(rowp + bj * HALF) = w; } }
    }
};
struct EpiResid {
    bf16_t* xr; float* ss;
    __device__ __forceinline__ void operator()(const f32x4 (&acc)[2][2][4][2], const Unit& u, int wr, int wc, int fr, int fq) const {
        const int row0 = u.pm * BM + wr * 64 + fr, col0 = u.pn * BM + wc * 32 + 8 * fq;
#pragma unroll
        for (int ai = 0; ai < 2; ++ai)
#pragma unroll
            for (int m = 0; m < 4; ++m) { const int row = row0 + ai * HALF + m * 16; const size_t ro = (size_t)row * D + col0; float sq = 0.f;
#pragma unroll
                for (int bj = 0; bj < 2; ++bj) { const u32x4 xv = *(const u32x4*)(xr + ro + bj * HALF);
                    const f32x4 a0 = (f32x4){bflo(xv.x), bfhi(xv.x), bflo(xv.y), bfhi(xv.y)}, a1 = (f32x4){bflo(xv.z), bfhi(xv.z), bflo(xv.w), bfhi(xv.w)};
                    const f32x4 o0 = a0 + acc[ai][bj][m][0], o1 = a1 + acc[ai][bj][m][1];
                    u32x4 w; w.x = pk2(o0[0], o0[1]); w.y = pk2(o0[2], o0[3]); w.z = pk2(o1[0], o1[1]); w.w = pk2(o1[2], o1[3]);
                    *(u32x4*)(xr + ro + bj * HALF) = w;
                    sq += ((o0[0] * o0[0] + o0[1] * o0[1]) + (o0[2] * o0[2] + o0[3] * o0[3])) + ((o1[0] * o1[0] + o1[1] * o1[1]) + (o1[2] * o1[2] + o1[3] * o1[3])); }
                sq += __shfl_xor(sq, 16); sq += __shfl_xor(sq, 32);
                if (fq == 0) ss[(size_t)row * 32 + u.pn * 4 + wc] = sq; }
    }
};
struct EpiSwiglu {
    bf16_t* U; const float* rstd;
    __device__ __forceinline__ void operator()(const f32x4 (&acc)[2][2][4][2], const Unit& u, int wr, int wc, int fr, int fq) const {
        const int row0 = u.pm * BM + wr * 64 + fr, col0 = u.pn * 128 + wc * 16 + 4 * fq;
        float rs[2][4];
#pragma unroll
        for (int ai = 0; ai < 2; ++ai)
#pragma unroll
            for (int m = 0; m < 4; ++m) rs[ai][m] = rstd[row0 + ai * HALF + m * 16];
#pragma unroll
        for (int ai = 0; ai < 2; ++ai)
#pragma unroll
            for (int m = 0; m < 4; ++m) { bf16_t* rowp = U + (size_t)(row0 + ai * HALF + m * 16) * FF + col0;
#pragma unroll
                for (int bj = 0; bj < 2; ++bj) { const f32x4 g = acc[ai][bj][m][0] * rs[ai][m], v = acc[ai][bj][m][1] * rs[ai][m]; float o[4];
#pragma unroll
                    for (int i = 0; i < 4; ++i) { const float e = __builtin_amdgcn_exp2f(-1.44269504089f * g[i]); o[i] = g[i] * __builtin_amdgcn_rcpf(1.0f + e) * v[i]; }
                    u32x2 w; w.x = pk2(o[0], o[1]); w.y = pk2(o[2], o[3]);
                    *(u32x2*)(rowp + bj * 64) = w; } }
    }
};

template <class Epi, class Sched>
__device__ __forceinline__ void gemm_phase(LAS unsigned char* lds, const Gemm g, const Sched& S, const Epi& E, const int tid) {
    const int wid = __builtin_amdgcn_readfirstlane(tid >> 6), lane = tid & 63, wr = wid >> 2, wc = wid & 3, fr = lane & 15, fq = lane >> 4;
    const int K = g.K, nt = K / BK;
    unsigned voffA[2], voffB[2];
#pragma unroll
    for (int i = 0; i < 2; ++i) { int R, C; stage_rc(tid * 16 + i * 8192, R, C); const int Rb = (R & ~31) + perm32(R & 31);
        voffA[i] = (unsigned)(R * g.lda + C) * 2u; voffB[i] = (unsigned)(Rb * g.ldb + C) * 2u; }
    const size_t kstep = (size_t)(BK * 2);
    const size_t hstepA = (size_t)HALF * g.lda * 2, hstepB = (size_t)HALF * g.ldb * 2;
    const size_t tstepA = 2 * hstepA, tstepB = 2 * hstepB, pnA = (size_t)g.apn * 2;
    const unsigned ldsw = (unsigned)wid * 1024u;
    const int aoff = lds_byte(wr * 64 + fr, fq * 8), boff = lds_byte(wc * 32 + fr, fq * 8);
#define PG8_SA(b, h) (((b) * 2 + (h)) * HTB)
#define PG8_SB(b, h) ((4 + (b) * 2 + (h)) * HTB)
#define PG8_STAGE(bufoff, gbase, voff) do { _Pragma("unroll") for (int _i = 0; _i < 2; ++_i) \
        __builtin_amdgcn_global_load_lds((const unsigned*)((const char*)(gbase) + (voff)[_i]), (LAS unsigned*)(lds + (bufoff) + ldsw + _i * 8192), 16, 0, 0); } while (0)
#define PG8_LDA(dst, b, h) do { _Pragma("unroll") for (int m = 0; m < 4; ++m) _Pragma("unroll") for (int k = 0; k < 2; ++k) dst[m][k] = *(const LAS bf16x8*)(lds + PG8_SA(b, h) + aoff + m * 2048 + k * 1024); } while (0)
#define PG8_LDB(dst, b, h) do { _Pragma("unroll") for (int n = 0; n < 2; ++n) _Pragma("unroll") for (int k = 0; k < 2; ++k) dst[n][k] = *(const LAS bf16x8*)(lds + PG8_SB(b, h) + boff + n * 2048 + k * 1024); } while (0)
#define PG8_MMA(ai, bj, At, Bt) do { __builtin_amdgcn_s_setprio(1); _Pragma("unroll") for (int m = 0; m < 4; ++m) _Pragma("unroll") for (int n = 0; n < 2; ++n) _Pragma("unroll") for (int k = 0; k < 2; ++k) \
        acc[ai][bj][m][n] = __builtin_amdgcn_mfma_f32_16x16x32_bf16(Bt[n][k], At[m][k], acc[ai][bj][m][n], 0, 0, 0); __builtin_amdgcn_s_setprio(0); } while (0)
#define PG8_WAIT_V(n) asm volatile("s_waitcnt vmcnt(" #n ")" ::: "memory")
#define PG8_WAIT_L(n) asm volatile("s_waitcnt lgkmcnt(" #n ")" ::: "memory")
#define PG8_BAR __builtin_amdgcn_s_barrier()
#define PG8_SCHED __builtin_amdgcn_sched_barrier(0)
    Unit cur, nxt; int ui = 0;
    if (!S.next(0, cur)) return;
    f32x4 acc[2][2][4][2];
#pragma unroll
    for (int a = 0; a < 2; ++a)
#pragma unroll
        for (int b = 0; b < 2; ++b)
#pragma unroll
            for (int m = 0; m < 4; ++m)
#pragma unroll
                for (int n = 0; n < 2; ++n) acc[a][b][m][n] = (f32x4){0.f, 0.f, 0.f, 0.f};
    bf16x8 At[4][2], B0[2][2], B1[2][2];
    const char* cA = (const char*)g.A + (size_t)cur.pm * tstepA + (size_t)cur.pn * pnA; const char* cB = (const char*)g.Bt + (size_t)cur.pn * tstepB;
    PG8_STAGE(PG8_SB(0, 0), cB, voffB); PG8_STAGE(PG8_SB(0, 1), cB + hstepB, voffB); PG8_STAGE(PG8_SA(0, 0), cA, voffA); PG8_STAGE(PG8_SA(0, 1), cA + hstepA, voffA);
    if (wr == 1) PG8_BAR;
    PG8_WAIT_V(2); PG8_BAR;
    PG8_STAGE(PG8_SB(1, 0), cB + kstep, voffB); PG8_STAGE(PG8_SA(1, 0), cA + kstep, voffA); PG8_STAGE(PG8_SB(1, 1), cB + hstepB + kstep, voffB);
    PG8_WAIT_V(6); PG8_BAR;
    for (;;) {
        const bool has_next = S.next(ui + 1, nxt);
        const char* nA = has_next ? (const char*)g.A + (size_t)nxt.pm * tstepA + (size_t)nxt.pn * pnA : cA; const char* nB = has_next ? (const char*)g.Bt + (size_t)nxt.pn * tstepB : cB;
        for (int t = 0; t < nt; t += 2) {
            const bool last = (t == nt - 2);
            const char* a1 = cA + (size_t)(t + 1) * kstep;
            const char* a2 = last ? nA : cA + (size_t)(t + 2) * kstep; const char* b2 = last ? nB : cB + (size_t)(t + 2) * kstep;
            const char* a3 = a2 + kstep; const char* b3 = b2 + kstep;
            PG8_LDB(B0, 0, 0); PG8_LDB(B1, 0, 1); PG8_SCHED; PG8_LDA(At, 0, 0); PG8_STAGE(PG8_SA(1, 1), a1 + hstepA, voffA);
            PG8_WAIT_V(8); PG8_WAIT_L(0); PG8_BAR; PG8_MMA(0, 0, At, B0); PG8_MMA(0, 1, At, B1); PG8_BAR; PG8_SCHED;
            PG8_LDA(At, 0, 1); PG8_STAGE(PG8_SB(0, 0), b2, voffB); PG8_STAGE(PG8_SB(0, 1), b2 + hstepB, voffB); PG8_STAGE(PG8_SA(0, 0), a2, voffA);
            PG8_WAIT_V(8); PG8_WAIT_L(0); PG8_BAR; PG8_MMA(1, 0, At, B0); PG8_MMA(1, 1, At, B1); PG8_BAR; PG8_SCHED;
            PG8_LDB(B0, 1, 0); PG8_LDB(B1, 1, 1); PG8_SCHED; PG8_LDA(At, 1, 0); PG8_STAGE(PG8_SA(0, 1), a2 + hstepA, voffA);
            PG8_WAIT_V(8); PG8_WAIT_L(0); PG8_BAR; PG8_MMA(0, 0, At, B0); PG8_MMA(0, 1, At, B1); PG8_BAR; PG8_SCHED;
            PG8_LDA(At, 1, 1); PG8_STAGE(PG8_SB(1, 0), b3, voffB); PG8_STAGE(PG8_SB(1, 1), b3 + hstepB, voffB); PG8_STAGE(PG8_SA(1, 0), a3, voffA);
            PG8_WAIT_V(8); PG8_WAIT_L(0); PG8_BAR; PG8_MMA(1, 0, At, B0); PG8_MMA(1, 1, At, B1); PG8_BAR; PG8_SCHED;
        }
        if (wr == 0) PG8_BAR;
        E(acc, cur, wr, wc, fr, fq);
        if (!has_next) break;
#pragma unroll
        for (int a = 0; a < 2; ++a)
#pragma unroll
            for (int b = 0; b < 2; ++b)
#pragma unroll
                for (int m = 0; m < 4; ++m)
#pragma unroll
                    for (int n = 0; n < 2; ++n) acc[a][b][m][n] = (f32x4){0.f, 0.f, 0.f, 0.f};
        cur = nxt; cA = nA; cB = nB; ++ui;
        if (wr == 1) PG8_BAR;
    }
    PG8_WAIT_V(0);
    PG8_BAR;
#undef PG8_SA
#undef PG8_SB
#undef PG8_STAGE
#undef PG8_LDA
#undef PG8_LDB
#undef PG8_MMA
#undef PG8_WAIT_V
#undef PG8_WAIT_L
#undef PG8_BAR
#undef PG8_SCHED
}
}

struct TrSeg { const float* W; int ldw, ncols, K; bf16_t* WT; int ldt, row_off, mode; const float* gain; };
__device__ __forceinline__ void tr_item(const TrSeg& s, int kb, int nb, LAS float* scr, int lane) {
    const int k0 = 64 * kb, n0 = 64 * nb;
    const int c4 = (lane & 15) * 4, kq = lane >> 4;
    const bool okc = (n0 + c4) < s.ncols;
    const float* src = s.W + (size_t)(k0 + kq) * s.ldw + n0 + c4;
    f32x4 v[16];
#pragma unroll
    for (int i = 0; i < 16; ++i) v[i] = okc ? *(const f32x4*)(src + (size_t)(4 * i) * s.ldw) : (f32x4){0.f, 0.f, 0.f, 0.f};
    if (s.gain) {
#pragma unroll
        for (int i = 0; i < 16; ++i) v[i] = v[i] * s.gain[k0 + 4 * i + kq]; }
#pragma unroll
    for (int i = 0; i < 16; ++i) { LAS float* d = scr + (4 * i + kq) * 65 + c4; d[0] = v[i][0]; d[1] = v[i][1]; d[2] = v[i][2]; d[3] = v[i][3]; }
    asm volatile("s_waitcnt lgkmcnt(0)" ::: "memory");
    const int c = lane & 7;
#pragma unroll
    for (int j = 0; j < 8; ++j) { const int n = (lane >> 3) + 8 * j, gn = n0 + n; const LAS float* sp = scr + (8 * c) * 65 + n;
        u32x4 o; o.x = pk2(sp[0 * 65], sp[1 * 65]); o.y = pk2(sp[2 * 65], sp[3 * 65]); o.z = pk2(sp[4 * 65], sp[5 * 65]); o.w = pk2(sp[6 * 65], sp[7 * 65]);
        const int row = s.mode ? (8 * (gn >> 2) + (gn & 3) + s.row_off) : (s.row_off + gn);
        if (gn < s.ncols) *(u32x4*)(s.WT + (size_t)row * s.ldt + k0 + 8 * c) = o; }
    asm volatile("s_waitcnt lgkmcnt(0)" ::: "memory");
}
__device__ __forceinline__ void tr_run(const TrSeg& s, int& next, int& base, int NGW, LAS float* scr, int lane) {
    const int nnb = (s.ncols + 63) >> 6, n = (s.K >> 6) * nnb;
    while (next < base + n) { const int it = next - base; tr_item(s, it / nnb, it % nnb, scr, lane); next += NGW; }
    base += n;
}
__device__ __forceinline__ void prologue_phase(const Params& p, const Ctx& cx, LAS unsigned char* lds) {
    const int wave = cx.wave, lane = cx.lane, G = cx.G, gw = cx.bid * 8 + wave, NGW = G * 8;
    LAS float* scr = (LAS float*)(lds + wave * 16640);
    unsigned char* ws = cx.ws;
    int next = gw, base = 0;
    for (int j = 0; j < 2; ++j) {
        const float* w_in = p.in[4] + (size_t)j * D * 6160;
        const float* gmix = p.in[1] + (size_t)(2 * j) * D;
        bf16_t* WinA = (bf16_t*)(ws + WS_W + j * GLA_STRIDE + GLA_WINA); bf16_t* Wv = (bf16_t*)(ws + WS_W + j * GLA_STRIDE + GLA_WV); bf16_t* Wo = (bf16_t*)(ws + WS_W + j * GLA_STRIDE + GLA_WOUT);
        { TrSeg s{w_in, 6160, 2048, D, WinA, D, 0, 0, gmix}; tr_run(s, next, base, NGW, scr, lane); }
        { TrSeg s{w_in + 2048, 6160, 2048, D, Wv, D, 0, 0, gmix}; tr_run(s, next, base, NGW, scr, lane); }
        { TrSeg s{w_in + 4096, 6160, 2048, D, WinA, D, 2048, 0, gmix}; tr_run(s, next, base, NGW, scr, lane); }
        { TrSeg s{w_in + 6144, 6160, 16, D, WinA, D, 4096, 0, gmix}; tr_run(s, next, base, NGW, scr, lane); }
        { TrSeg s{p.in[8] + (size_t)j * D * D, D, D, D, Wo, D, 0, 0, nullptr}; tr_run(s, next, base, NGW, scr, lane); }
    }
    for (int j = 0; j < 2; ++j) {
        bf16_t* Win = (bf16_t*)(ws + DSA_BASE + j * DSA_STRIDE + DSA_WIN); bf16_t* Wuv = (bf16_t*)(ws + DSA_BASE + j * DSA_STRIDE + DSA_WUV); bf16_t* Wo = (bf16_t*)(ws + DSA_BASE + j * DSA_STRIDE + DSA_WOUT);
        { TrSeg s{p.in[9] + (size_t)j * D * 6544, 6544, 6544, D, Win, D, 0, 0, p.in[1] + (size_t)(2 * j + 1) * D}; tr_run(s, next, base, NGW, scr, lane); }
        for (int h = 0; h < 16; ++h) {
            TrSeg s{p.in[12] + (size_t)(j * 16 + h) * 256 * 128, 128, 128, 256, Wuv + (size_t)((h >> 1) * 256 + (h & 1) * 128) * 512 + (h & 1) * 256, 512, 0, 0, nullptr};
            tr_run(s, next, base, NGW, scr, lane);
        }
        { TrSeg s{p.in[13] + (size_t)j * D * D, D, D, D, Wo, D, 0, 0, nullptr}; tr_run(s, next, base, NGW, scr, lane); }
        for (int i = cx.bid * 512 + cx.tid; i < 65536; i += G * 512) {
            const int blk = i >> 12, r = (i >> 5) & 127, ch = i & 31, pn = blk >> 1, hh = blk & 1;
            *(u32x4*)(Wuv + (size_t)(pn * 256 + hh * 128 + r) * 512 + (1 - hh) * 256 + ch * 8) = (u32x4){0u, 0u, 0u, 0u};
        }
    }
    for (int i = 0; i < 4; ++i) {
        bf16_t* W13 = (bf16_t*)(ws + FFN_BASE + i * FFN_STRIDE + FFN_W13); bf16_t* W2 = (bf16_t*)(ws + FFN_BASE + i * FFN_STRIDE + FFN_W2);
        { TrSeg s{p.in[15] + (size_t)i * D * FF, FF, FF, D, W13, D, 0, 1, p.in[2] + (size_t)i * D}; tr_run(s, next, base, NGW, scr, lane); }
        { TrSeg s{p.in[16] + (size_t)i * D * FF, FF, FF, D, W13, D, 4, 1, p.in[2] + (size_t)i * D}; tr_run(s, next, base, NGW, scr, lane); }
        { TrSeg s{p.in[17] + (size_t)i * FF * D, D, D, FF, W2, FF, 0, 0, nullptr}; tr_run(s, next, base, NGW, scr, lane); }
    }
    bf16_t* XR = (bf16_t*)(ws + WS_XR); float* RS = (float*)(ws + WS_RSTD);
    for (int m = gw; m < M; m += NGW) {
        const f32x4* xr = (const f32x4*)(p.in[0] + (size_t)m * D) + lane; u32x2* o = (u32x2*)(XR + (size_t)m * D) + lane; float sq = 0.f;
#pragma unroll
        for (int jq = 0; jq < 8; ++jq) { const f32x4 v = xr[64 * jq]; sq += (v[0] * v[0] + v[1] * v[1]) + (v[2] * v[2] + v[3] * v[3]); u32x2 w; w.x = pk2(v[0], v[1]); w.y = pk2(v[2], v[3]); o[64 * jq] = w; }
        sq = wave_sum(sq);
        if (lane == 0) RS[m] = 1.0f / sqrtf(sq * (1.0f / D) + RMS_EPS);
    }
}

template <bool BF16IN, bool F32OUT>
__device__ __forceinline__ void rms_phase(const void* xp, const float* g, void* outp, const Ctx& cx) {
    const int lane = cx.lane, gw = cx.bid * 8 + cx.wave, NGW = cx.G * 8;
    f32x4 gv[8], nx[8];
#pragma unroll
    for (int j = 0; j < 8; ++j) gv[j] = ((const f32x4*)g)[lane + 64 * j];
#define RMS_LOAD(ROW) do { if (BF16IN) { const u32x2* xr_ = (const u32x2*)((const bf16_t*)xp + (size_t)(ROW) * D) + lane; \
            _Pragma("unroll") for (int j = 0; j < 8; ++j) { const u32x2 t_ = xr_[64 * j]; nx[j] = (f32x4){bflo(t_.x), bfhi(t_.x), bflo(t_.y), bfhi(t_.y)}; } } \
        else { const f32x4* xr_ = (const f32x4*)((const float*)xp + (size_t)(ROW) * D) + lane; _Pragma("unroll") for (int j = 0; j < 8; ++j) nx[j] = xr_[64 * j]; } } while (0)
    if (gw < M) RMS_LOAD(gw);
    for (int m = gw; m < M; m += NGW) {
        f32x4 v[8]; float s = 0.f;
#pragma unroll
        for (int j = 0; j < 8; ++j) v[j] = nx[j];
        if (m + NGW < M) RMS_LOAD(m + NGW);
#pragma unroll
        for (int j = 0; j < 8; ++j) s += (v[j][0] * v[j][0] + v[j][1] * v[j][1]) + (v[j][2] * v[j][2] + v[j][3] * v[j][3]);
        s = wave_sum(s);
        const float r = 1.0f / sqrtf(s * (1.0f / D) + RMS_EPS);
        if (F32OUT) { f32x4* o = (f32x4*)((float*)outp + (size_t)m * D) + lane;
#pragma unroll
            for (int j = 0; j < 8; ++j) o[64 * j] = v[j] * r * gv[j];
        } else { u32x2* o = (u32x2*)((bf16_t*)outp + (size_t)m * D) + lane;
#pragma unroll
            for (int j = 0; j < 8; ++j) { const f32x4 y = v[j] * r * gv[j]; u32x2 w; w.x = pk2(y[0], y[1]); w.y = pk2(y[2], y[3]); o[64 * j] = w; } }
    }
#undef RMS_LOAD
}
__device__ __forceinline__ void rstd_phase(const Ctx& cx) {
    const float* SS = (const float*)(cx.ws + WS_SS); float* RS = (float*)(cx.ws + WS_RSTD);
    for (int m = cx.bid * 512 + cx.tid; m < M; m += cx.G * 512) {
        const f32x4* sp = (const f32x4*)(SS + (size_t)m * 32); float t = 0.f;
#pragma unroll
        for (int q = 0; q < 8; ++q) { const f32x4 a = sp[q]; t += (a[0] + a[1]) + (a[2] + a[3]); }
        RS[m] = 1.0f / sqrtf(t * (1.0f / D) + RMS_EPS);
    }
}
__device__ __forceinline__ float fexp(float x) { return __builtin_amdgcn_exp2f(x * 1.44269504089f); }
__device__ __forceinline__ float log_sigmoid(float z) { return fminf(z, 0.f) - __builtin_amdgcn_logf(1.0f + fexp(-fabsf(z))) * 0.69314718056f; }
__device__ __forceinline__ void gla_gate_phase(const Params& p, const Ctx& cx, int j, LAS unsigned char* lds) {
    const bf16_t* P1 = (const bf16_t*)(cx.ws + WS_P); bf16_t* KDT = (bf16_t*)(cx.ws + WS_KDT); float* DEC = (float*)(cx.ws + WS_DEC);
    const bf16_t* H = (const bf16_t*)(cx.ws + WS_XR); const float* RS = (const float*)(cx.ws + WS_RSTD); const bf16_t* Wa = (const bf16_t*)(cx.ws + WS_W + (size_t)j * GLA_STRIDE + GLA_WINA) + (size_t)4096 * D;
    const float* w_a2 = p.in[5] + (size_t)j * 16 * 1024; const float* b_a = p.in[6] + (size_t)j * 1024;
    const int wave = cx.wave, lane = cx.lane, fr = lane & 15, fq = lane >> 4;
    LAS float* al = (LAS float*)(lds + 32768);
    for (int it = cx.bid; it < 512; it += cx.G) {
        const int bc = it >> 1, kcol = (it & 1) * 512 + cx.tid, b = bc >> 6, c = bc & 63, tok0 = b * T + c * 64;
        __syncthreads();
        {
            f32x4 acc[4];
#pragma unroll
            for (int tt = 0; tt < 4; ++tt) acc[tt] = (f32x4){0.f, 0.f, 0.f, 0.f};
            const bf16_t* hp = H + (size_t)(tok0 + fr) * D + 256 * wave + 8 * fq;
            const bf16_t* wp = Wa + (size_t)fr * D + 256 * wave + 8 * fq;
#pragma unroll
            for (int ss = 0; ss < 8; ++ss) { const bf16x8 bfg = *(const bf16x8*)(wp + 32 * ss);
#pragma unroll
                for (int tt = 0; tt < 4; ++tt) { const bf16x8 afg = *(const bf16x8*)(hp + (size_t)(16 * tt) * D + 32 * ss); acc[tt] = mfma16(afg, bfg, acc[tt]); } }
#pragma unroll
            for (int tt = 0; tt < 4; ++tt) *(LAS f32x4*)(lds + ((wave * 4 + tt) * 64 + lane) * 16) = acc[tt];
        }
        __syncthreads();
        if (cx.tid < 256) { const int tt = cx.tid >> 6, l2 = cx.tid & 63;
            f32x4 v = *(const LAS f32x4*)(lds + (tt * 64 + l2) * 16);
#pragma unroll
            for (int w8 = 1; w8 < 8; ++w8) v = v + *(const LAS f32x4*)(lds + ((w8 * 4 + tt) * 64 + l2) * 16);
            const int tokl = 16 * tt + 4 * (l2 >> 4), r = l2 & 15;
            const f32x4 rq = *(const f32x4*)(RS + tok0 + tokl);
#pragma unroll
            for (int i = 0; i < 4; ++i) al[(tokl + i) * 16 + r] = v[i] * rq[i]; }
        __syncthreads();
        float w[16];
#pragma unroll
        for (int r = 0; r < 16; ++r) w[r] = w_a2[r * 1024 + kcol];
        const float bias = b_a[kcol];
        float cum = 0.f;
        for (int t = 0; t < 64; ++t) {
            const LAS f32x4* ap = (const LAS f32x4*)(al + t * 16); const f32x4 a0 = ap[0], a1 = ap[1], a2 = ap[2], a3 = ap[3];
            float z = bias;
#pragma unroll
            for (int r = 0; r < 4; ++r) { z += a0[r] * w[r] + a1[r] * w[4 + r]; z += a2[r] * w[8 + r] + a3[r] * w[12 + r]; }
            cum += log_sigmoid(z) * (1.0f / 16.0f);
        }
        const float ltot = cum; cum = 0.f;
        for (int t8 = 0; t8 < 8; ++t8) {
            float kd[8];
#pragma unroll
            for (int e = 0; e < 8; ++e) {
                const int t = 8 * t8 + e;
                const LAS f32x4* ap = (const LAS f32x4*)(al + t * 16); const f32x4 a0 = ap[0], a1 = ap[1], a2 = ap[2], a3 = ap[3];
                float z = bias;
#pragma unroll
                for (int r = 0; r < 4; ++r) { z += a0[r] * w[r] + a1[r] * w[4 + r]; z += a2[r] * w[8 + r] + a3[r] * w[12 + r]; }
                cum += log_sigmoid(z) * (1.0f / 16.0f);
                kd[e] = bf2f(P1[(size_t)(tok0 + t) * P1_LD + P1_K + kcol]) * fexp(ltot - cum) * RS[tok0 + t];
            }
            u32x4 o; o.x = pk2(kd[0], kd[1]); o.y = pk2(kd[2], kd[3]); o.z = pk2(kd[4], kd[5]); o.w = pk2(kd[6], kd[7]);
            *(u32x4*)(KDT + (size_t)kcol * M + tok0 + 8 * t8) = o;
        }
        DEC[(size_t)bc * 1024 + kcol] = fexp(ltot);
    }
}

constexpr int SC_KDB = 144, SC_QB = 528, SC_KD_BYTES = 256 * SC_KDB, SC_DEC_OFF = SC_KD_BYTES + 64 * SC_QB, SC_BUF = SC_DEC_OFF + 1024, SC_PART = SC_BUF;
__device__ __forceinline__ void gla_scan_phase(const Params& p, const Ctx& cx, LAS unsigned char* lds) {
    const bf16_t* P1 = (const bf16_t*)(cx.ws + WS_P); const bf16_t* VT = (const bf16_t*)(cx.ws + WS_VT); const bf16_t* KDT = (const bf16_t*)(cx.ws + WS_KDT);
    const float* DEC = (const float*)(cx.ws + WS_DEC); bf16_t* O = (bf16_t*)(cx.ws + WS_O);
    const int tid = cx.tid, wave = cx.wave, lane = cx.lane, G = cx.G, fr = lane & 15, fq = lane >> 4;
    const int vt = wave & 1, kq = wave >> 1;
    for (int item = cx.bid; item < 256; item += G) {
        int bh, vg; if (G == 256) { const int r_ = item >> 3; bh = (item & 7) + 8 * (r_ >> 4); vg = r_ & 15; } else { bh = item >> 4; vg = item & 15; }
        const int b = bh >> 2, h = bh & 3, v0 = vg * 32 + vt * 16;
        const bf16_t* gk = KDT + (size_t)(h * 256 + (tid >> 3)) * M + b * T + (tid & 7) * 8;
        const bf16_t* gq = P1 + (size_t)(b * T + (tid >> 5)) * P1_LD + P1_Q + h * 256 + (tid & 31) * 8;
        const float* gd = DEC + (size_t)(b * 64) * 1024 + h * 256 + (tid & 63) * 4;
        const int lk = (tid >> 3) * SC_KDB + (tid & 7) * 16, lq = SC_KD_BYTES + (tid >> 5) * SC_QB + (tid & 31) * 16;
        u32x4 pk[4], pq[4]; f32x4 pd = (f32x4){0.f, 0.f, 0.f, 0.f};
        __syncthreads();
#pragma unroll
        for (int i = 0; i < 4; ++i) { pk[i] = *(const u32x4*)(gk + (size_t)i * 64 * M); pq[i] = *(const u32x4*)(gq + (size_t)i * 16 * P1_LD); }
        if (tid < 64) pd = *(const f32x4*)gd;
#pragma unroll
        for (int i = 0; i < 4; ++i) { *(LAS u32x4*)(lds + lk + i * 64 * SC_KDB) = pk[i]; *(LAS u32x4*)(lds + lq + i * 16 * SC_QB) = pq[i]; }
        if (tid < 64) *(LAS f32x4*)(lds + SC_DEC_OFF + tid * 16) = pd;
        __syncthreads();
        f32x4 S[4];
#pragma unroll
        for (int i = 0; i < 4; ++i) S[i] = (f32x4){0.f, 0.f, 0.f, 0.f};
        const bf16_t* vtrow = VT + (size_t)(h * 512 + v0 + fr) * M + b * T + 8 * fq;
        bf16x8 nv0 = *(const bf16x8*)vtrow, nv1 = *(const bf16x8*)(vtrow + 32);
        const LAS unsigned char* kdb = lds + (64 * kq + fr) * SC_KDB + 16 * fq;
        const LAS unsigned char* decl = lds + SC_DEC_OFF + 256 * kq + 16 * fq;
        const LAS unsigned char* qb = lds + SC_KD_BYTES + fr * SC_QB + 128 * kq + 8 * fq;
        LAS unsigned char* pw = lds + SC_PART + wave * 4096 + lane * 16;
        const LAS unsigned char* pr = lds + SC_PART + vt * 4096 + kq * 1024 + lane * 16;
        for (int c = 0; c < 64; ++c) {
            const int tokc = c * 64;
            const bf16x8 vf0 = nv0, vf1 = nv1;
            if (c + 1 < 64) {
#pragma unroll
                for (int i = 0; i < 4; ++i) { pk[i] = *(const u32x4*)(gk + (size_t)i * 64 * M + tokc + 64); pq[i] = *(const u32x4*)(gq + (size_t)i * 16 * P1_LD + (size_t)(tokc + 64) * P1_LD); }
                nv0 = *(const bf16x8*)(vtrow + tokc + 64); nv1 = *(const bf16x8*)(vtrow + tokc + 96); if (tid < 64) pd = *(const f32x4*)(gd + (size_t)(c + 1) * 1024);
            }
#pragma unroll
            for (int j = 0; j < 4; ++j) {
                const f32x4 d = *(const LAS f32x4*)(decl + 64 * j);
                const bf16x8 a0 = *(const LAS bf16x8*)(kdb + j * 16 * SC_KDB), a1 = *(const LAS bf16x8*)(kdb + j * 16 * SC_KDB + 64);
                f32x4 sv = S[j] * d;
                sv = mfma16(a0, vf0, sv); sv = mfma16(a1, vf1, sv); S[j] = sv;
            }
            bf16x8 sf[2];
#pragma unroll
            for (int ks = 0; ks < 2; ++ks) { u32x4 w; w.x = pk2(S[2 * ks][0], S[2 * ks][1]); w.y = pk2(S[2 * ks][2], S[2 * ks][3]); w.z = pk2(S[2 * ks + 1][0], S[2 * ks + 1][1]); w.w = pk2(S[2 * ks + 1][2], S[2 * ks + 1][3]);
                sf[ks] = __builtin_bit_cast(bf16x8, w); }
#pragma unroll
            for (int ct = 0; ct < 4; ++ct) {
                f32x4 o = (f32x4){0.f, 0.f, 0.f, 0.f};
#pragma unroll
                for (int ks = 0; ks < 2; ++ks) {
                    const u32x2 q0 = *(const LAS u32x2*)(qb + ct * 16 * SC_QB + 64 * ks), q1 = *(const LAS u32x2*)(qb + ct * 16 * SC_QB + 64 * ks + 32);
                    u32x4 qw; qw.x = q0.x; qw.y = q0.y; qw.z = q1.x; qw.w = q1.y;
                    o = mfma16(sf[ks], __builtin_bit_cast(bf16x8, qw), o);
                }
                *(LAS f32x4*)(pw + ct * 1024) = o;
            }
            __syncthreads();
            {
                f32x4 o = *(const LAS f32x4*)pr;
#pragma unroll
                for (int k2 = 1; k2 < 4; ++k2) o = o + *(const LAS f32x4*)(pr + k2 * 8192);
                u32x2 w; w.x = pk2(o[0] * 0.0625f, o[1] * 0.0625f); w.y = pk2(o[2] * 0.0625f, o[3] * 0.0625f);
                *(u32x2*)(O + (size_t)(b * T + tokc + 16 * kq + fr) * D + h * 512 + v0 + 4 * fq) = w;
            }
            if (c + 1 < 64) {
#pragma unroll
                for (int i = 0; i < 4; ++i) { *(LAS u32x4*)(lds + lk + i * 64 * SC_KDB) = pk[i]; *(LAS u32x4*)(lds + lq + i * 16 * SC_QB) = pq[i]; }
                if (tid < 64) *(LAS f32x4*)(lds + SC_DEC_OFF + tid * 16) = pd;
            }
            __syncthreads();
        }
    }
}

__device__ __forceinline__ void gla_normgate_phase(const Params& p, const Ctx& cx, int j) {
    const int wave = cx.wave, lane = cx.lane;
    const bf16_t* P1 = (const bf16_t*)(cx.ws + WS_P); const bf16_t* O = (const bf16_t*)(cx.ws + WS_O); bf16_t* A2 = (bf16_t*)(cx.ws + WS_H);
    const float* gn = p.in[7] + (size_t)j * 512 + lane * 8;
    const f32x4 g0 = *(const f32x4*)gn, g1 = *(const f32x4*)(gn + 4);
    const int gw = cx.bid * 8 + wave, NGW = cx.G * 8;
    u32x4 no[4], ng[4];
    if (gw < M) {
#pragma unroll
        for (int h = 0; h < 4; ++h) { no[h] = *(const u32x4*)(O + (size_t)gw * D + h * 512 + lane * 8); ng[h] = *(const u32x4*)(P1 + (size_t)gw * P1_LD + P1_G + h * 512 + lane * 8); }
    }
    for (int tok = gw; tok < M; tok += NGW) {
        u32x4 ovv[4], gvv[4];
#pragma unroll
        for (int h = 0; h < 4; ++h) { ovv[h] = no[h]; gvv[h] = ng[h]; }
        if (tok + NGW < M) {
#pragma unroll
            for (int h = 0; h < 4; ++h) { no[h] = *(const u32x4*)(O + (size_t)(tok + NGW) * D + h * 512 + lane * 8); ng[h] = *(const u32x4*)(P1 + (size_t)(tok + NGW) * P1_LD + P1_G + h * 512 + lane * 8); }
        }
#pragma unroll
        for (int h = 0; h < 4; ++h) {
            const u32x4 ov = ovv[h], gv = gvv[h];
            float v[8], g[8];
#pragma unroll
            for (int i = 0; i < 4; ++i) { v[2 * i] = bflo(ov[i]); v[2 * i + 1] = bfhi(ov[i]); g[2 * i] = bflo(gv[i]); g[2 * i + 1] = bfhi(gv[i]); }
            float ss = 0.f;
#pragma unroll
            for (int i = 0; i < 8; ++i) ss += v[i] * v[i];
            ss = wave_sum(ss);
            const float r = __builtin_amdgcn_rsqf(ss * (1.0f / 512.0f) + RMS_EPS);
            float y[8];
#pragma unroll
            for (int i = 0; i < 8; ++i) { const float gg = (i < 4) ? g0[i] : g1[i - 4]; y[i] = v[i] * r * gg * (g[i] * __builtin_amdgcn_rcpf(1.0f + fexp(-g[i]))); }
            u32x4 w; w.x = pk2(y[0], y[1]); w.y = pk2(y[2], y[3]); w.z = pk2(y[4], y[5]); w.w = pk2(y[6], y[7]);
            *(u32x4*)(A2 + (size_t)tok * D + h * 512 + lane * 8) = w;
        }
    }
}

__device__ __forceinline__ void dsa_post_phase(const Params& p, const Ctx& cx, int j) {
    const int wave = cx.wave, lane = cx.lane;
    const bf16_t* P2 = (const bf16_t*)(cx.ws + WS_P); bf16_t* CN = (bf16_t*)(cx.ws + WS_CN); bf16_t* KI = (bf16_t*)(cx.ws + WS_KI); float* WI = (float*)(cx.ws + WS_WI);
    const f32x4 kvn = *(const f32x4*)(p.in[10] + (size_t)j * 256 + lane * 4);
    const float kn0 = p.in[11][(size_t)j * 128 + lane * 2], kn1 = p.in[11][(size_t)j * 128 + lane * 2 + 1];
    const int gw = cx.bid * 8 + wave, NGW = cx.G * 8;
    for (int m = gw; m < M; m += NGW) {
        const bf16_t* row = P2 + (size_t)m * P2_LD;
        const u32x2 cv = *(const u32x2*)(row + P2_C + lane * 4);
        const float c0 = bflo(cv.x), c1 = bfhi(cv.x), c2 = bflo(cv.y), c3 = bfhi(cv.y);
        float ss = wave_sum((c0 * c0 + c1 * c1) + (c2 * c2 + c3 * c3));
        float r = 1.0f / sqrtf(ss * (1.0f / 256.0f) + RMS_EPS);
        u32x2 w; w.x = pk2(c0 * r * kvn[0], c1 * r * kvn[1]); w.y = pk2(c2 * r * kvn[2], c3 * r * kvn[3]);
        *(u32x2*)(CN + (size_t)m * 256 + lane * 4) = w;
        const unsigned kv = *(const unsigned*)(row + P2_KI + lane * 2);
        const float k0 = bflo(kv), k1 = bfhi(kv);
        ss = wave_sum(k0 * k0 + k1 * k1);
        r = 1.0f / sqrtf(ss * (1.0f / 128.0f) + RMS_EPS);
        *(unsigned*)(KI + (size_t)m * 128 + lane * 2) = pk2(k0 * r * kn0, k1 * r * kn1);
        if (lane < 16) WI[(size_t)m * 16 + lane] = bf2f(row[P2_WI + lane]) * (0.25f * 0.08838834764831845f);
    }
}

__device__ __forceinline__ void dsa_index_phase(const Params& p, const Ctx& cx, LAS unsigned char* lds) {
    const int wave = cx.wave, lane = cx.lane;
    const bf16_t* P2 = (const bf16_t*)(cx.ws + WS_P); const bf16_t* KI = (const bf16_t*)(cx.ws + WS_KI); const float* WI = (const float*)(cx.ws + WS_WI); int* IDX = (int*)(cx.ws + WS_IDX);
    const int G = cx.G;
    const int pair = wave >> 1, kh = wave & 1, rho = lane & 31, hA = lane >> 5;
    for (int k = 0;; ++k) {
        const int it = cx.bid + k * G; if (it >= 2048) break;
        int b, pos; if (G == 256) { b = k >> 1; pos = (k & 1) ? 511 - cx.bid : cx.bid; } else { b = it >> 9; pos = it & 511; }
        const int q0 = pos * 8, nch = (q0 >> 6) + 1, ntile = 2 * nch;
        {
            const int qA = q0 + 2 * pair + ((rho >> 2) & 1), headA = (rho & 3) + 4 * (rho >> 3);
            const bf16_t* qip = P2 + (size_t)(b * T + qA) * P2_LD + P2_QI + headA * 128 + 8 * hA;
            bf16x8 af[8];
#pragma unroll
            for (int s = 0; s < 8; ++s) af[s] = *(const bf16x8*)(qip + 16 * s);
            const float* wp = WI + (size_t)(b * T + q0 + 2 * pair + hA) * 16;
            f32x4 w4[4];
#pragma unroll
            for (int i = 0; i < 4; ++i) w4[i] = *(const f32x4*)(wp + 4 * i);
            LAS float* sc = (LAS float*)lds + (2 * pair + hA) * 4096;
            LAS unsigned char* stg = lds + 131072;
            const char* kub = (const char*)(KI + (size_t)(b * T) * 128);
            const unsigned kvo = (unsigned)(((cx.tid >> 4) * 128 + (cx.tid & 15) * 8) * 2);
#define KLD(TILE, HALF_) (*(const u32x4*)(kub + (size_t)(TILE) * 16384 + (size_t)(HALF_) * 8192 + kvo))
            const int sto = (cx.tid >> 4) * 272 + (cx.tid & 15) * 16;
            __builtin_amdgcn_s_waitcnt(0);
            u32x4 rA0 = KLD(0, 0), rA1 = KLD(0, 1), rB0 = rA0, rB1 = rA1;
            if (nch > 1) { rB0 = KLD(1, 0); rB1 = KLD(1, 1); }
            const LAS unsigned char* brd = stg + (kh * 32 + rho) * 272 + 16 * hA;
#define IDX_TILE(R0, R1, TILE) do { \
                __syncthreads(); \
                *(LAS u32x4*)(stg + sto) = R0; *(LAS u32x4*)(stg + sto + 32 * 272) = R1; \
                __syncthreads(); \
                if ((TILE) + 2 < nch) { R0 = KLD((TILE) + 2, 0); R1 = KLD((TILE) + 2, 1); } \
                bf16x8 bfr[8]; \
                _Pragma("unroll") for (int s = 0; s < 8; ++s) bfr[s] = *(const LAS bf16x8*)(brd + 32 * s); \
                f32x16 acc, acc2; \
                _Pragma("unroll") for (int i = 0; i < 16; ++i) { acc[i] = 0.f; acc2[i] = 0.f; } \
                _Pragma("unroll") for (int s = 0; s < 4; ++s) { acc = mfma32(af[2 * s], bfr[2 * s], acc); acc2 = mfma32(af[2 * s + 1], bfr[2 * s + 1], acc2); } \
                float v = 0.f, v2 = 0.f; \
                _Pragma("unroll") for (int i = 0; i < 16; i += 2) { v += w4[i >> 2][i & 3] * fmaxf(acc[i] + acc2[i], 0.f); v2 += w4[(i + 1) >> 2][(i + 1) & 3] * fmaxf(acc[i + 1] + acc2[i + 1], 0.f); } \
                v += v2; \
                sc[(TILE) * 64 + kh * 32 + rho] = v; } while (0)
            for (int tile = 0; tile < nch; tile += 2) {
                IDX_TILE(rA0, rA1, tile);
                if (tile + 1 < nch) IDX_TILE(rB0, rB1, tile + 1);
            }
#undef IDX_TILE
#undef KLD
        }
        __syncthreads();
        {
            const LAS unsigned* su = (const LAS unsigned*)lds + wave * 4096 + lane;
            unsigned u[64];
#pragma unroll
            for (int jj = 0; jj < 64; ++jj) { unsigned x = 0u; if (jj < nch) { const unsigned bits = su[jj * 64]; x = (bits & 0x80000000u) ? ~bits : (bits | 0x80000000u); } u[jj] = x; }
            int* ip = IDX + (size_t)(b * T + q0 + wave) * 256;
            if (nch <= 4) {
#pragma unroll
                for (int jj = 0; jj < 4; ++jj) ip[jj * 64 + lane] = (jj < nch) ? jj * 64 + lane : -1;
            } else {
                unsigned Tt = 0u;
                for (int bit = 31; bit >= 0; --bit) {
                    const unsigned cand = Tt | (1u << bit); int cnt = 0;
#pragma unroll
                    for (int g8 = 0; g8 < 8; ++g8) { if (g8 * 8 < nch) {
#pragma unroll
                        for (int jj = g8 * 8; jj < g8 * 8 + 8; ++jj) cnt += __builtin_popcountll(__ballot(u[jj] >= cand)); } }
                    if (cnt >= 256) Tt = cand;
                    if (cnt == 256) break;
                }
                int basep = 0;
#pragma unroll
                for (int jj = 0; jj < 64; ++jj) { if (jj >= nch) continue; const bool sel = u[jj] > Tt; const unsigned long long mk = __ballot(sel);
                    const int ps = basep + (int)__builtin_amdgcn_mbcnt_hi((unsigned)(mk >> 32), __builtin_amdgcn_mbcnt_lo((unsigned)mk, 0u));
                    if (sel) ip[ps] = jj * 64 + lane; basep += __builtin_popcountll(mk); }
#pragma unroll
                for (int jj = 0; jj < 64; ++jj) { if (jj >= nch) continue; const bool sel = u[jj] == Tt; const unsigned long long mk = __ballot(sel);
                    const int ps = basep + (int)__builtin_amdgcn_mbcnt_hi((unsigned)(mk >> 32), __builtin_amdgcn_mbcnt_lo((unsigned)mk, 0u));
                    if (sel && ps < 256) ip[ps] = jj * 64 + lane; basep += __builtin_popcountll(mk); }
            }
        }
        __syncthreads();
    }
}

constexpr int AT_ROWB = 528, AT_WAVEB = 32 * AT_ROWB, AT_BIAS = 8 * AT_WAVEB;
__device__ __forceinline__ s16x4 ld_tr(const LAS unsigned char* ptr) { return __builtin_bit_cast(s16x4, __builtin_amdgcn_ds_read_tr16_b64_v4i16((LAS s16x4*)ptr)); }
__device__ __forceinline__ int att_tok(const Ctx& cx, int k, int wloc) {
    if (cx.G == 256) return (k < 8) ? ((cx.bid & 7) >> 1) * T + k * 512 + wloc : -1;
    const int tok = cx.bid * 8 + cx.wave + k * cx.G * 8; return tok < M ? tok : -1;
}
#define ATT_GATHER(IR, SBLO, BB) do { const bf16_t* cb_ = CN + (size_t)(BB) * T * 256 + (lane & 31) * 8; _Pragma("unroll") for (int i_ = 0; i_ < 16; ++i_) { const int kidx_ = __shfl((IR), 32 * (SBLO) + 2 * i_ + (lane >> 5)); const unsigned kk_ = kidx_ < 0 ? 0u : (unsigned)kidx_; \
        g[i_] = *(const u32x4*)(cb_ + kk_ * 256u); if ((i_ & 3) == 3) asm volatile("" ::: "memory"); } } while (0)
__device__ __forceinline__ void dsa_attn_phase(const Params& p, const Ctx& cx, LAS unsigned char* lds) {
    const int wave = cx.wave, lane = cx.lane;
    const bf16_t* P2 = (const bf16_t*)(cx.ws + WS_P); const bf16_t* CN = (const bf16_t*)(cx.ws + WS_CN); const int* IDX = (const int*)(cx.ws + WS_IDX); bf16_t* OB = (bf16_t*)(cx.ws + WS_OB);
    LAS float* lb = (LAS float*)(lds + AT_BIAS);
    for (int e_ = cx.tid; e_ < 256 * 16; e_ += 512) { const int rel = (e_ >> 4) - 128, hd = e_ & 15, n = rel < 0 ? -rel : rel;
        const int large = 8 + (n >= 12) + (n >= 16) + (n >= 23) + (n >= 32) + (n >= 46) + (n >= 64) + (n >= 91);
        const int bk = ((rel > 0) ? 16 : 0) + ((n < 8) ? n : large);
        lb[e_] = p.in[14][bk * 16 + hd]; }
    __syncthreads();
    LAS unsigned char* wl = lds + wave * AT_WAVEB;
    const int fr = lane & 15, fq = lane >> 4;
    const int wloc = ((cx.bid & 1) * 32 + (cx.bid >> 3)) * 8 + wave;
    int tok = att_tok(cx, 0, wloc);
    int ir0 = 0, ir1 = 0, ir2 = 0, ir3 = 0;
    u32x4 g[16];
    if (tok >= 0) { const int* ip = IDX + (size_t)tok * 256 + lane; ir0 = ip[0]; ir1 = ip[64]; ir2 = ip[128]; ir3 = ip[192]; }
    for (int k = 0; tok >= 0; ++k) {
        const int b = tok >> 12, t = tok & (T - 1);
        const int ntok = att_tok(cx, k + 1, wloc);
        int nr0 = 0, nr1 = 0, nr2 = 0, nr3 = 0;
        if (ntok >= 0) { const int* ip = IDX + (size_t)ntok * 256 + lane; nr0 = ip[0]; nr1 = ip[64]; nr2 = ip[128]; nr3 = ip[192]; }
        const bf16_t* qp = P2 + (size_t)tok * P2_LD + P2_Q + fr * 256 + 8 * fq;
        float m_run = -INFINITY, l_run = 0.f;
        f32x4 oacc[16];
#pragma unroll
        for (int i = 0; i < 16; ++i) oacc[i] = (f32x4){0.f, 0.f, 0.f, 0.f};
        for (int sb = 0; sb < 8; ++sb) {
            const int h2 = sb >> 1, irc = (h2 == 0) ? ir0 : (h2 == 1) ? ir1 : (h2 == 2) ? ir2 : ir3;
            ATT_GATHER(irc, sb & 1, b);
#pragma unroll
            for (int i = 0; i < 16; ++i) *(LAS u32x4*)(wl + (2 * i + (lane >> 5)) * AT_ROWB + (lane & 31) * 16) = g[i];
            int kx[8];
#pragma unroll
            for (int e = 0; e < 8; ++e) kx[e] = __shfl(irc, 32 * (sb & 1) + 16 * (e >> 2) + 4 * fq + (e & 3));
            bf16x8 qf[8];
            { size_t qo_ = 0; asm volatile("" : "+s"(qo_));
#pragma unroll
              for (int s = 0; s < 8; ++s) qf[s] = *(const bf16x8*)(qp + qo_ + 32 * s); }
            asm volatile("s_waitcnt lgkmcnt(0)" ::: "memory");
            f32x4 sacc[2];
#pragma unroll
            for (int kt2 = 0; kt2 < 2; ++kt2) { f32x4 a = (f32x4){0.f, 0.f, 0.f, 0.f};
#pragma unroll
                for (int s = 0; s < 8; ++s) { const bf16x8 cf = *(const LAS bf16x8*)(wl + (16 * kt2 + fr) * AT_ROWB + (32 * s + 8 * fq) * 2); a = mfma16(cf, qf[s], a); if ((s & 3) == 3) asm volatile("" ::: "memory"); }
                sacc[kt2] = a; }
            float lg[8];
#pragma unroll
            for (int e = 0; e < 8; ++e) { const int kidx = kx[e]; const float a = ((e < 4) ? sacc[0][e & 3] : sacc[1][e & 3]) * 0.0625f;
                int rel = kidx - t; rel = rel < -128 ? -128 : (rel > 127 ? 127 : rel);
                const float bias = lb[(rel + 128) * 16 + fr];
                lg[e] = (kidx < 0) ? -INFINITY : a + bias; }
            float bm = fmaxf(fmaxf(fmaxf(lg[0], lg[1]), fmaxf(lg[2], lg[3])), fmaxf(fmaxf(lg[4], lg[5]), fmaxf(lg[6], lg[7])));
            bm = fmaxf(bm, __shfl_xor(bm, 16)); bm = fmaxf(bm, __shfl_xor(bm, 32));
            const float m_new = fmaxf(m_run, bm), scale = __expf(m_run - m_new);
            float pe[8], psum = 0.f;
#pragma unroll
            for (int e = 0; e < 8; ++e) { pe[e] = __expf(lg[e] - m_new); psum += pe[e]; }
            l_run = l_run * scale + psum; m_run = m_new;
#pragma unroll
            for (int i = 0; i < 16; ++i) oacc[i] = oacc[i] * scale;
            u32x4 pw; pw.x = pk2(pe[0], pe[1]); pw.y = pk2(pe[2], pe[3]); pw.z = pk2(pe[4], pe[5]); pw.w = pk2(pe[6], pe[7]);
            const bf16x8 pf = __builtin_bit_cast(bf16x8, pw);
            const LAS unsigned char* tb = wl + (4 * fq + ((lane & 15) >> 2)) * AT_ROWB + 8 * (lane & 3);
#pragma unroll
            for (int lt = 0; lt < 16; ++lt) {
                const s16x4 t0 = ld_tr(tb + 32 * lt), t1 = ld_tr(tb + 16 * AT_ROWB + 32 * lt);
                bf16x8 cf; cf[0] = t0[0]; cf[1] = t0[1]; cf[2] = t0[2]; cf[3] = t0[3]; cf[4] = t1[0]; cf[5] = t1[1]; cf[6] = t1[2]; cf[7] = t1[3];
                oacc[lt] = mfma16(cf, pf, oacc[lt]);
                if ((lt & 3) == 3) asm volatile("" ::: "memory");
            }
            asm volatile("s_waitcnt lgkmcnt(0)" ::: "memory");
        }
        float lt_ = l_run + __shfl_xor(l_run, 16); lt_ += __shfl_xor(lt_, 32);
        const float inv = 1.0f / lt_;
        bf16_t* op = OB + (size_t)tok * 4096 + fr * 256 + 4 * fq;
#pragma unroll
        for (int lt = 0; lt < 16; ++lt) { u32x2 w; w.x = pk2(oacc[lt][0] * inv, oacc[lt][1] * inv); w.y = pk2(oacc[lt][2] * inv, oacc[lt][3] * inv); *(u32x2*)(op + 16 * lt) = w; }
        tok = ntok; ir0 = nr0; ir1 = nr1; ir2 = nr2; ir3 = nr3;
    }
    __syncthreads();
}

#define XB_TMO      128
#define XB_XCNT(j)  (256  + 64 * (j))
#define XB_XSUB(j)  (1280 + 64 * (j))
#define XB_XGEN(j)  (2304 + 64 * (j))
#define XB_TOP      3328
#define XB_TOPGEN   3392
#define XCD_BAR_WORDS 3456
#define XB_SPIN_CAP (1u << 22)
__device__ __forceinline__ unsigned xb_ld(unsigned* p)              { return __hip_atomic_load(p, __ATOMIC_RELAXED, __HIP_MEMORY_SCOPE_AGENT); }
__device__ __forceinline__ unsigned xb_add(unsigned* p, unsigned v) { return __hip_atomic_fetch_add(p, v, __ATOMIC_RELAXED, __HIP_MEMORY_SCOPE_AGENT); }
__device__ __forceinline__ unsigned xb_xcc_id() { return (unsigned)__builtin_amdgcn_s_getreg((3 << 11) | 20) & 0xFu; }
#define XB_SPIN(cond, bar) do { unsigned _sp = 0; while (cond) { __builtin_amdgcn_s_sleep(1); \
    if ((++_sp & 255u) == 0u) { if (xb_ld(&(bar)[XB_TMO])) break; if (_sp > XB_SPIN_CAP) { atomicAdd(&(bar)[XB_TMO], 1u); break; } } } } while (0)
struct XcdBarrier { unsigned* bar; unsigned x; volatile LAS unsigned* st; };
__device__ __forceinline__ XcdBarrier xcd_barrier_post(unsigned* bar, volatile LAS unsigned* st) {
    XcdBarrier b; b.bar = bar; b.x = xb_xcc_id(); b.st = st;
    if (threadIdx.x == 0) (void)xb_add(&bar[XB_XCNT(b.x)], 1u);
    return b;
}
__device__ __forceinline__ void xcd_barrier_complete(unsigned* bar, unsigned x, unsigned& nloc, unsigned& nx) {
    const unsigned G = gridDim.x * gridDim.y * gridDim.z;
    unsigned sum, cnt, mine, sp = 0u;
    for (;;) {
        sum = 0u; cnt = 0u; mine = 0u;
#pragma unroll
        for (unsigned j = 0; j < 16; ++j) { const unsigned c = xb_ld(&bar[XB_XCNT(j)]); sum += c; cnt += (c > 0u) ? 1u : 0u; mine = (j == x) ? c : mine; }
        if (sum == G) break;
        __builtin_amdgcn_s_sleep(1);
        if ((++sp & 255u) == 0u) { if (xb_ld(&bar[XB_TMO])) break; if (sp > XB_SPIN_CAP) { atomicAdd(&bar[XB_TMO], 1u); break; } }
    }
    nloc = mine > 0u ? mine : 1u; nx = cnt > 0u ? cnt : 1u;
}
__device__ __forceinline__ void xcd_barrier(const XcdBarrier& b) {
    asm volatile("s_waitcnt vmcnt(0)" ::: "memory");
    __syncthreads();
    if (threadIdx.x == 0) {
        unsigned* bar = b.bar;
        __builtin_amdgcn_s_waitcnt(0);
        unsigned nloc = b.st[0], nx = b.st[1];
        if (nloc == 0u) { xcd_barrier_complete(bar, b.x, nloc, nx); b.st[0] = nloc; b.st[1] = nx; }
        const unsigned old = xb_add(&bar[XB_XSUB(b.x)], 1u);
        const unsigned gen = old / nloc;
        if (old + 1u == (gen + 1u) * nloc) {
            __builtin_amdgcn_fence(__ATOMIC_RELEASE, "agent");
            asm volatile("s_waitcnt vmcnt(0)" ::: "memory");
            const unsigned og = xb_add(&bar[XB_TOP], 1u);
            const unsigned tg = og / nx;
            if (og + 1u == (tg + 1u) * nx) xb_add(&bar[XB_TOPGEN], 1u);
            else XB_SPIN(xb_ld(&bar[XB_TOPGEN]) == tg, bar);
            __builtin_amdgcn_fence(__ATOMIC_ACQUIRE, "agent");
            xb_add(&bar[XB_XGEN(b.x)], 1u);
            asm volatile("s_waitcnt vmcnt(0)" ::: "memory");
        } else {
            XB_SPIN(xb_ld(&bar[XB_XGEN(b.x)]) == gen, bar);
            __builtin_amdgcn_fence(__ATOMIC_ACQUIRE, "agent");
            asm volatile("s_waitcnt vmcnt(0)" ::: "memory");
        }
    }
    __syncthreads();
}

constexpr int N_PHASES = 42;
__host__ __device__ inline bool phase_is_nop(int ph) { if (ph == 0 || ph == 41) return false; const int L = (ph - 1) / 10, s = (ph - 1) % 10; return (L == 0 && s == 0) || ((!(L & 1)) && s == 6); }

__host__ __device__ inline int phase_kind(int ph) {
    if (ph == 0) return 0; if (ph == 41) return 1;
    const int L = (ph - 1) / 10, s = (ph - 1) % 10; const bool gla = !(L & 1);
    if (s == 0 || s == 7) return 1; if (s == 1 || (!gla && s == 5)) return 2; if ((gla && s == 5) || (!gla && s == 6) || s == 9) return 3; if (s == 8) return 4;
    if (gla) return 3 + s; return 6 + s;
}
__global__ void __launch_bounds__(512, 2) trunk_fwd(Params p) {
    extern __shared__ __attribute__((aligned(16))) unsigned char smem[];
    LAS unsigned char* lds = (LAS unsigned char*)smem;
    volatile LAS unsigned* bst = (volatile LAS unsigned*)(lds + LDS_CTL);
    if (threadIdx.x < 64) bst[threadIdx.x] = 0u;
    __syncthreads();
    XcdBarrier gbar = xcd_barrier_post((unsigned*)p.ws, bst);
    if (p.ph_lo > 1000) cg::this_grid().sync();
    for (int ph = p.ph_lo, rep_ = 0; ph < p.ph_hi;) {
        if (phase_is_nop(ph)) { ++ph; continue; }
        int b_ = blockIdx.x; asm volatile("" : "+s"(b_)); int g_ = gridDim.x; asm volatile("" : "+s"(g_));
        size_t z_ = 0; asm volatile("" : "+s"(z_)); unsigned char* ws = p.ws + z_;
#define MKCX Ctx cx; { int t_ = threadIdx.x; asm volatile("" : "+v"(t_)); cx.tid = t_; cx.lane = t_ & 63; cx.wave = __builtin_amdgcn_readfirstlane(t_ >> 6); cx.bid = b_; cx.G = g_; cx.ws = ws; }
        bf16_t* Hb = (bf16_t*)(ws + WS_H); bf16_t* Pb = (bf16_t*)(ws + WS_P); bf16_t* XRp = (bf16_t*)(ws + WS_XR); const float* RSk = (const float*)(ws + WS_RSTD);
        if (ph == 0) { if (PHON(0)) { MKCX; prologue_phase(p, cx, lds); } }
        else if (ph == 41) { if (PHON(1)) { MKCX; rms_phase<true, true>(ws + WS_XR, p.in[3], p.out, cx); } }
        else {
            const int L = (ph - 1) / 10, s = (ph - 1) % 10, j = L >> 1; const bool gla = !(L & 1);
            unsigned char* wg = ws + WS_W + j * GLA_STRIDE; unsigned char* wd = ws + DSA_BASE + j * DSA_STRIDE; unsigned char* wf = ws + FFN_BASE + L * FFN_STRIDE;
            if (s == 0) { if (PHON(1)) { MKCX; rstd_phase(cx); } }
            else if (s == 7) { if (PHON(1)) { MKCX; rstd_phase(cx); } }
            else if (s == 1 || (!gla && s == 5)) {
                const int ng = (gla && s == 1) ? 2 : 1;
                for (int gi = 0; gi < ng; ++gi) {
                    pg8::Gemm g; pg8::EpiStore E;
                    if (gla) {
                        if (gi == 0) { g = pg8::Gemm{XRp, (const bf16_t*)(wg + GLA_WINA), M, 4096, D, D, D, 0}; E = pg8::EpiStore{Pb, P1_LD, RSk}; }
                        else { g = pg8::Gemm{(const bf16_t*)(wg + GLA_WV), XRp, D, M, D, D, D, 0}; E = pg8::EpiStore{(bf16_t*)(ws + WS_VT), M, nullptr}; }
                    } else if (s == 1) { g = pg8::Gemm{XRp, (const bf16_t*)(wd + DSA_WIN), M, P2_LD, D, D, D, 0}; E = pg8::EpiStore{Pb, P2_LD, RSk}; }
                    else { g = pg8::Gemm{(const bf16_t*)(ws + WS_OB), (const bf16_t*)(wd + DSA_WUV), M, D, 512, 4096, 512, 512}; E = pg8::EpiStore{Hb, D, nullptr}; }
                    pg8::StaticOrder S; S.init(g.M, g.N, g_, b_); int t2_ = threadIdx.x; asm volatile("" : "+v"(t2_));
                    if (PHON(2)) pg8::gemm_phase(lds, g, S, E, t2_);
                }
            } else if ((gla && s == 5) || (!gla && s == 6) || s == 9) {
                pg8::Gemm g;
                if (s == 9) g = pg8::Gemm{Pb, (const bf16_t*)(wf + FFN_W2), M, D, FF, FF, FF, 0};
                else g = pg8::Gemm{Hb, (const bf16_t*)(gla ? wg + GLA_WOUT : wd + DSA_WOUT), M, D, D, D, D, 0};
                pg8::EpiResid E{XRp, (float*)(ws + WS_SS)};
                pg8::StaticOrder S; S.init(g.M, g.N, g_, b_); int t2_ = threadIdx.x; asm volatile("" : "+v"(t2_));
                if (PHON(3)) pg8::gemm_phase(lds, g, S, E, t2_);
            } else if (s == 8) {
                pg8::Gemm g{XRp, (const bf16_t*)(wf + FFN_W13), M, 2 * FF, D, D, D, 0};
                pg8::EpiSwiglu E{Pb, RSk};
                pg8::StaticOrder S; S.init(g.M, g.N, g_, b_); int t2_ = threadIdx.x; asm volatile("" : "+v"(t2_));
                if (PHON(4)) pg8::gemm_phase(lds, g, S, E, t2_);
            } else if (gla) {
                if (s == 2) { if (PHON(5)) { MKCX; gla_gate_phase(p, cx, j, lds); } }
                else if (s == 3) { if (PHON(6)) { MKCX; gla_scan_phase(p, cx, lds); } }
                else if (s == 4) { if (PHON(7)) { MKCX; gla_normgate_phase(p, cx, j); } }
            } else {
                if (s == 2) { if (PHON(8)) { MKCX; dsa_post_phase(p, cx, j); } }
                else if (s == 3) { if (PHON(9)) { MKCX; dsa_index_phase(p, cx, lds); } }
                else if (s == 4) { if (PHON(10)) { MKCX; dsa_attn_phase(p, cx, lds); } }
            }
        }
        if (ph + 1 < p.ph_hi) { xcd_barrier(gbar); if ((REP_MASK >> 11) & 1) xcd_barrier(gbar); }
        if (REP_MASK && rep_ == 0 && phase_kind(ph) != 3 && ((REP_MASK >> phase_kind(ph)) & 1)) rep_ = 1; else { rep_ = 0; ++ph; }
    }
}

extern "C" void kernel_launch(void* const* d_in, const int* in_sizes, int n_in, void* d_out, int out_size, void* d_ws, size_t ws_size, hipStream_t stream) {
    static int grid = 0;
    if (!grid) {
        if (n_in != 18 || out_size != M * D || ws_size < WS_END) { fprintf(stderr, "kernel_launch: unexpected shapes (n_in %d out %d ws %zu)\n", n_in, out_size, ws_size); grid = -1; return; }
        int dev = 0, cus = 0, per_cu = 0;
        hipGetDevice(&dev); hipDeviceGetAttribute(&cus, hipDeviceAttributeMultiprocessorCount, dev);
        if (hipFuncSetAttribute((const void*)trunk_fwd, hipFuncAttributeMaxDynamicSharedMemorySize, LDS_BYTES) != hipSuccess) { fprintf(stderr, "kernel_launch: hipFuncSetAttribute failed\n"); grid = -1; return; }
        hipOccupancyMaxActiveBlocksPerMultiprocessor(&per_cu, (const void*)trunk_fwd, 512, LDS_BYTES);
        if (per_cu < 1) per_cu = 1;
        grid = cus * per_cu;
        fprintf(stderr, "kernel_launch: grid %d (cus %d x %d)\n", grid, cus, per_cu);
    }
    if (grid < 0) return;
    if (hipMemsetAsync(d_ws, 0, XCD_BAR_WORDS * 4, stream) != hipSuccess) { fprintf(stderr, "kernel_launch: memset failed\n"); return; }
    Params p{};
    for (int i = 0; i < 18; ++i) p.in[i] = (const float*)d_in[i];
    p.out = (float*)d_out; p.ws = (unsigned char*)d_ws;
#if MK_MULTI
    for (int ph = 0; ph < N_PHASES; ++ph) {
        if (phase_is_nop(ph)) continue;
        p.ph_lo = ph; p.ph_hi = ph + 1;
        hipLaunchKernelGGL(trunk_fwd, dim3(grid), dim3(512), LDS_BYTES, stream, p);
    }
#else
    p.ph_lo = 0; p.ph_hi = N_PHASES;
    void* args[] = {&p};
    hipError_t e = hipLaunchCooperativeKernel((const void*)trunk_fwd, dim3(grid), dim3(512), args, LDS_BYTES, stream);
    if (e != hipSuccess) fprintf(stderr, "cooperative launch failed: %s (grid %d)\n", hipGetErrorString(e), grid);
#endif
}
```

```cpp
#include <hip/hip_runtime.h>
#include <hip/hip_cooperative_groups.h>
#include <cstdio>
#include <cstdint>
namespace cg = cooperative_groups;

#ifndef PH_MASK
#define PH_MASK 0xFFFF
#endif
#define PHON(k) ((PH_MASK >> (k)) & 1)
#ifndef REP_MASK
#define REP_MASK 0
#endif
#ifndef MK_MULTI
#define MK_MULTI 0
#endif

#define LAS __attribute__((address_space(3)))
typedef unsigned short bf16_t;
typedef short bf16x8 __attribute__((ext_vector_type(8)));
typedef short s16x4 __attribute__((ext_vector_type(4)));
typedef float f32x4 __attribute__((ext_vector_type(4)));
typedef float f32x16 __attribute__((ext_vector_type(16)));
typedef unsigned u32x4 __attribute__((ext_vector_type(4)));
typedef unsigned u32x2 __attribute__((ext_vector_type(2)));
typedef int i32x4 __attribute__((ext_vector_type(4)));

constexpr int NB = 4, T = 4096, M = NB * T, D = 2048, FF = 5632;
constexpr int P1_LD = 4352, P1_Q = 0, P1_K = 1024, P1_G = 2048, P1_A = 4096;
constexpr int P2_LD = 6656, P2_Q = 0, P2_C = 4096, P2_QI = 4352, P2_KI = 6400, P2_WI = 6528;
constexpr float RMS_EPS = 1e-6f;

constexpr size_t MiB = 1u << 20;
constexpr size_t WS_W = 1 * MiB;
constexpr size_t GLA_STRIDE = 33 * MiB, GLA_WINA = 0, GLA_WV = 17 * MiB, GLA_WOUT = 25 * MiB;
constexpr size_t DSA_BASE = WS_W + 66 * MiB, DSA_STRIDE = 36 * MiB, DSA_WIN = 0, DSA_WUV = 26 * MiB, DSA_WOUT = 28 * MiB;
constexpr size_t FFN_BASE = WS_W + 138 * MiB, FFN_STRIDE = 66 * MiB, FFN_W13 = 0, FFN_W2 = 44 * MiB;
constexpr size_t WS_H = 403 * MiB, WS_P = 467 * MiB, WS_VT = 603 * MiB, WS_X2 = 675 * MiB;
constexpr size_t WS_KDT = WS_X2, WS_DEC = WS_X2 + 32 * MiB, WS_O = WS_X2 + 33 * MiB;
constexpr size_t WS_CN = WS_X2, WS_KI = WS_X2 + 8 * MiB, WS_WI = WS_X2 + 12 * MiB, WS_IDX = WS_X2 + 13 * MiB, WS_OB = WS_X2 + 29 * MiB;
constexpr size_t WS_XR = 832 * MiB;
constexpr size_t WS_RSTD = 896 * MiB, WS_SS = 897 * MiB;
constexpr size_t WS_END = 900 * MiB;
constexpr int LDS_BYTES = 163840, LDS_CTL = 163584;

struct Params { const float* in[18]; float* out; unsigned char* ws; int ph_lo, ph_hi; };
struct Ctx { int tid, lane, wave, bid, G; unsigned char* ws; };

__device__ __forceinline__ float bf2f(bf16_t u) { return __builtin_bit_cast(float, (unsigned)u << 16); }
__device__ __forceinline__ float bflo(unsigned u) { return __builtin_bit_cast(float, u << 16); }
__device__ __forceinline__ float bfhi(unsigned u) { return __builtin_bit_cast(float, u & 0xffff0000u); }
typedef __bf16 bf16x2_t __attribute__((ext_vector_type(2)));
typedef float f32x2_t __attribute__((ext_vector_type(2)));
__device__ __forceinline__ unsigned pk2(float lo, float hi) { const f32x2_t v = {lo, hi}; const bf16x2_t b = __builtin_convertvector(v, bf16x2_t); return __builtin_bit_cast(unsigned, b); }
__device__ __forceinline__ float wave_sum(float v) {
#pragma unroll
    for (int o = 1; o < 64; o <<= 1) v += __shfl_xor(v, o);
    return v;
}
__device__ __forceinline__ f32x4 mfma16(bf16x8 a, bf16x8 b, f32x4 c) { return __builtin_amdgcn_mfma_f32_16x16x32_bf16(a, b, c, 0, 0, 0); }
__device__ __forceinline__ f32x16 mfma32(bf16x8 a, bf16x8 b, f32x16 c) { return __builtin_amdgcn_mfma_f32_32x32x16_bf16(a, b, c, 0, 0, 0); }

namespace pg8 {
constexpr int BM = 256, BK = 64, HALF = 128, HTB = HALF * BK * 2, STAGE_BYTES = 8 * HTB, NXCD = 8, WGM = 8;
__host__ __device__ __forceinline__ int lds_byte(int r, int c) { const int st = (r >> 4) * 2 + (c >> 5), rr = r & 15, cc = c & 31, ob = rr * 64 + cc * 2; return st * 1024 + (ob ^ (((ob >> 9) & 1) << 5)); }
__host__ __device__ __forceinline__ void stage_rc(int b, int& R, int& C) { const int st = b / 1024, sb = b % 1024, swz = sb ^ (((sb >> 9) & 1) << 5); R = (st >> 1) * 16 + swz / 64; C = (st & 1) * 32 + (swz % 64) / 2; }
__host__ __device__ __forceinline__ int perm32(int rho) { const int n = rho >> 4, i = rho & 15; return 8 * (i >> 2) + 4 * n + (i & 3); }

struct Unit { int pm, pn; };
struct Gemm { const bf16_t* A; const bf16_t* Bt; int M, N, K, lda, ldb, apn; };

struct StaticOrder {
    int nM, nN, nwg, G, c;
    __device__ void init(int M_, int N_, int G_, int c_) { nM = M_ / BM; nN = N_ / BM; nwg = nM * nN; G = G_; c = c_; }
    __device__ bool next(int i, Unit& u) const {
        const long L = (long)i * G + c; if (L >= nwg) return false;
        int wgid = (int)L; { const int q = nwg / NXCD, r = nwg % NXCD, xcd = wgid % NXCD, off = wgid / NXCD; wgid = (xcd < r ? xcd * (q + 1) : r * (q + 1) + (xcd - r) * q) + off; }
        const int nig = WGM * nN, gid = wgid / nig, fm = gid * WGM, gsz = (nM - fm) < WGM ? (nM - fm) : WGM;
        u.pm = fm + ((wgid % nig) % gsz); u.pn = (wgid % nig) / gsz; return true;
    }
};

struct EpiStore {
    bf16_t* O; int ldc; const float* rstd;
    __device__ __forceinline__ void operator()(const f32x4 (&acc)[2][2][4][2], const Unit& u, int wr, int wc, int fr, int fq) const {
        const int row0 = u.pm * BM + wr * 64 + fr, col0 = u.pn * BM + wc * 32 + 8 * fq;
        float rs[2][4];
#pragma unroll
        for (int ai = 0; ai < 2; ++ai)
#pragma unroll
            for (int m = 0; m < 4; ++m) rs[ai][m] = rstd ? rstd[row0 + ai * HALF + m * 16] : 1.0f;
#pragma unroll
        for (int ai = 0; ai < 2; ++ai)
#pragma unroll
            for (int m = 0; m < 4; ++m) { bf16_t* rowp = O + (size_t)(row0 + ai * HALF + m * 16) * ldc + col0;
#pragma unroll
                for (int bj = 0; bj < 2; ++bj) { const f32x4 v0 = acc[ai][bj][m][0] * rs[ai][m], v1 = acc[ai][bj][m][1] * rs[ai][m];
                    u32x4 w; w.x = pk2(v0[0], v0[1]); w.y = pk2(v0[2], v0[3]); w.z = pk2(v1[0], v1[1]); w.w = pk2(v1[2], v1[3]);
                    *(u32x4*)(rowp + bj * HALF) = w; } }
    }
};
struct EpiResid {
    bf16_t* xr; float* ss;
    __device__ __forceinline__ void operator()(const f32x4 (&acc)[2][2][4][2], const Unit& u, int wr, int wc, int fr, int fq) const {
        const int row0 = u.pm * BM + wr * 64 + fr, col0 = u.pn * BM + wc * 32 + 8 * fq;
#pragma unroll
        for (int ai = 0; ai < 2; ++ai)
#pragma unroll
            for (int m = 0; m < 4; ++m) { const int row = row0 + ai * HALF + m * 16; const size_t ro = (size_t)row * D + col0; float sq = 0.f;
#pragma unroll
                for (int bj = 0; bj < 2; ++bj) { const u32x4 xv = *(const u32x4*)(xr + ro + bj * HALF);
                    const f32x4 a0 = (f32x4){bflo(xv.x), bfhi(xv.x), bflo(xv.y), bfhi(xv.y)}, a1 = (f32x4){bflo(xv.z), bfhi(xv.z), bflo(xv.w), bfhi(xv.w)};
                    const f32x4 o0 = a0 + acc[ai][bj][m][0], o1 = a1 + acc[ai][bj][m][1];
                    u32x4 w; w.x = pk2(o0[0], o0[1]); w.y = pk2(o0[2], o0[3]); w.z = pk2(o1[0], o1[1]); w.w = pk2(o1[2], o1[3]);
                    *(u32x4*)(xr + ro + bj * HALF) = w;
                    sq += ((o0[0] * o0[0] + o0[1] * o0[1]) + (o0[2] * o0[2] + o0[3] * o0[3])) + ((o1[0] * o1[0] + o1[1] * o1[1]) + (o1[2] * o1[2] + o1[3] * o1[3])); }
                sq += __shfl_xor(sq, 16); sq += __shfl_xor(sq, 32);
                if (fq == 0) ss[(size_t)row * 32 + u.pn * 4 + wc] = sq; }
    }
};
struct EpiSwiglu {
    bf16_t* U; const float* rstd;
    __device__ __forceinline__ void operator()(const f32x4 (&acc)[2][2][4][2], const Unit& u, int wr, int wc, int fr, int fq) const {
        const int row0 = u.pm * BM + wr * 64 + fr, col0 = u.pn * 128 + wc * 16 + 4 * fq;
        float rs[2][4];
#pragma unroll
        for (int ai = 0; ai < 2; ++ai)
#pragma unroll
            for (int m = 0; m < 4; ++m) rs[ai][m] = rstd[row0 + ai * HALF + m * 16];
#pragma unroll
        for (int ai = 0; ai < 2; ++ai)
#pragma unroll
            for (int m = 0; m < 4; ++m) { bf16_t* rowp = U + (size_t)(row0 + ai * HALF + m * 16) * FF + col0;
#pragma unroll
                for (int bj = 0; bj < 2; ++bj) { const f32x4 g = acc[ai][bj][m][0] * rs[ai][m], v = acc[ai][bj][m][1] * rs[ai][m]; float o[4];
#pragma unroll
                    for (int i = 0; i < 4; ++i) { const float e = __builtin_amdgcn_exp2f(-1.44269504089f * g[i]); o[i] = g[i] * __builtin_amdgcn_rcpf(1.0f + e) * v[i]; }
                    u32x2 w; w.x = pk2(o[0], o[1]); w.y = pk2(o[2], o[3]);
                    *(u32x2*)(rowp + bj * 64) = w; } }
    }
};

template <class Epi, class Sched>
__device__ __forceinline__ void gemm_phase(LAS unsigned char* lds, const Gemm g, const Sched& S, const Epi& E, const int tid) {
    const int wid = __builtin_amdgcn_readfirstlane(tid >> 6), lane = tid & 63, wr = wid >> 2, wc = wid & 3, fr = lane & 15, fq = lane >> 4;
    const int K = g.K, nt = K / BK;
    unsigned voffA[2], voffB[2];
#pragma unroll
    for (int i = 0; i < 2; ++i) { int R, C; stage_rc(tid * 16 + i * 8192, R, C); const int Rb = (R & ~31) + perm32(R & 31);
        voffA[i] = (unsigned)(R * g.lda + C) * 2u; voffB[i] = (unsigned)(Rb * g.ldb + C) * 2u; }
    const size_t kstep = (size_t)(BK * 2);
    const size_t hstepA = (size_t)HALF * g.lda * 2, hstepB = (size_t)HALF * g.ldb * 2;
    const size_t tstepA = 2 * hstepA, tstepB = 2 * hstepB, pnA = (size_t)g.apn * 2;
    const unsigned ldsw = (unsigned)wid * 1024u;
    const int aoff = lds_byte(wr * 64 + fr, fq * 8), boff = lds_byte(wc * 32 + fr, fq * 8);
#define PG8_SA(b, h) (((b) * 2 + (h)) * HTB)
#define PG8_SB(b, h) ((4 + (b) * 2 + (h)) * HTB)
#define PG8_STAGE(bufoff, gbase, voff) do { _Pragma("unroll") for (int _i = 0; _i < 2; ++_i) \
        __builtin_amdgcn_global_load_lds((const unsigned*)((const char*)(gbase) + (voff)[_i]), (LAS unsigned*)(lds + (bufoff) + ldsw + _i * 8192), 16, 0, 0); } while (0)
#define PG8_LDA(dst, b, h) do { _Pragma("unroll") for (int m = 0; m < 4; ++m) _Pragma("unroll") for (int k = 0; k < 2; ++k) dst[m][k] = *(const LAS bf16x8*)(lds + PG8_SA(b, h) + aoff + m * 2048 + k * 1024); } while (0)
#define PG8_LDB(dst, b, h) do { _Pragma("unroll") for (int n = 0; n < 2; ++n) _Pragma("unroll") for (int k = 0; k < 2; ++k) dst[n][k] = *(const LAS bf16x8*)(lds + PG8_SB(b, h) + boff + n * 2048 + k * 1024); } while (0)
#define PG8_MMA(ai, bj, At, Bt) do { __builtin_amdgcn_s_setprio(1); _Pragma("unroll") for (int m = 0; m < 4; ++m) _Pragma("unroll") for (int n = 0; n < 2; ++n) _Pragma("unroll") for (int k = 0; k < 2; ++k) \
        acc[ai][bj][m][n] = __builtin_amdgcn_mfma_f32_16x16x32_bf16(Bt[n][k], At[m][k], acc[ai][bj][m][n], 0, 0, 0); __builtin_amdgcn_s_setprio(0); } while (0)
#define PG8_WAIT_V(n) asm volatile("s_waitcnt vmcnt(" #n ")" ::: "memory")
#define PG8_WAIT_L(n) asm volatile("s_waitcnt lgkmcnt(" #n ")" ::: "memory")
#define PG8_BAR __builtin_amdgcn_s_barrier()
#define PG8_SCHED __builtin_amdgcn_sched_barrier(0)
    Unit cur, nxt; int ui = 0;
    if (!S.next(0, cur)) return;
    f32x4 acc[2][2][4][2];
#pragma unroll
    for (int a = 0; a < 2; ++a)
#pragma unroll
        for (int b = 0; b < 2; ++b)
#pragma unroll
            for (int m = 0; m < 4; ++m)
#pragma unroll
                for (int n = 0; n < 2; ++n) acc[a][b][m][n] = (f32x4){0.f, 0.f, 0.f, 0.f};
    bf16x8 At[4][2], B0[2][2], B1[2][2];
    const char* cA = (const char*)g.A + (size_t)cur.pm * tstepA + (size_t)cur.pn * pnA; const char* cB = (const char*)g.Bt + (size_t)cur.pn * tstepB;
    PG8_STAGE(PG8_SB(0, 0), cB, voffB); PG8_STAGE(PG8_SB(0, 1), cB + hstepB, voffB); PG8_STAGE(PG8_SA(0, 0), cA, voffA); PG8_STAGE(PG8_SA(0, 1), cA + hstepA, voffA);
    if (wr == 1) PG8_BAR;
    PG8_WAIT_V(2); PG8_BAR;
    PG8_STAGE(PG8_SB(1, 0), cB + kstep, voffB); PG8_STAGE(PG8_SA(1, 0), cA + kstep, voffA); PG8_STAGE(PG8_SB(1, 1), cB + hstepB + kstep, voffB);
    PG8_WAIT_V(6); PG8_BAR;
    for (;;) {
        const bool has_next = S.next(ui + 1, nxt);
        const char* nA = has_next ? (const char*)g.A + (size_t)nxt.pm * tstepA + (size_t)nxt.pn * pnA : cA; const char* nB = has_next ? (const char*)g.Bt + (size_t)nxt.pn * tstepB : cB;
        for (int t = 0; t < nt; t += 2) {
            const bool last = (t == nt - 2);
            const char* a1 = cA + (size_t)(t + 1) * kstep;
            const char* a2 = last ? nA : cA + (size_t)(t + 2) * kstep; const char* b2 = last ? nB : cB + (size_t)(t + 2) * kstep;
            const char* a3 = a2 + kstep; const char* b3 = b2 + kstep;
            PG8_LDB(B0, 0, 0); PG8_LDB(B1, 0, 1); PG8_SCHED; PG8_LDA(At, 0, 0); PG8_STAGE(PG8_SA(1, 1), a1 + hstepA, voffA);
            PG8_WAIT_V(8); PG8_WAIT_L(0); PG8_BAR; PG8_MMA(0, 0, At, B0); PG8_MMA(0, 1, At, B1); PG8_BAR; PG8_SCHED;
            PG8_LDA(At, 0, 1); PG8_STAGE(PG8_SB(0, 0), b2, voffB); PG8_STAGE(PG8_SB(0, 1), b2 + hstepB, voffB); PG8_STAGE(PG8_SA(0, 0), a2, voffA);
            PG8_WAIT_V(8); PG8_WAIT_L(0); PG8_BAR; PG8_MMA(1, 0, At, B0); PG8_MMA(1, 1, At, B1); PG8_BAR; PG8_SCHED;
            PG8_LDB(B0, 1, 0); PG8_LDB(B1, 1, 1); PG8_SCHED; PG8_LDA(At, 1, 0); PG8_STAGE(PG8_SA(0, 1), a2 + hstepA, voffA);
            PG8_WAIT_V(8); PG8_WAIT_L(0); PG8_BAR; PG8_MMA(0, 0, At, B0); PG8_MMA(0, 1, At, B1); PG8_BAR; PG8_SCHED;
            PG8_LDA(At, 1, 1); PG8_STAGE(PG8_SB(1, 0), b3, voffB); PG8_STAGE(PG8_SB(1, 1), b3 + hstepB, voffB); PG8_STAGE(PG8_SA(1, 0), a3, voffA);
            PG8_WAIT_V(8); PG8_WAIT_L(0); PG8_BAR; PG8_MMA(1, 0, At, B0); PG8_MMA(1, 1, At, B1); PG8_BAR; PG8_SCHED;
        }
        if (wr == 0) PG8_BAR;
        E(acc, cur, wr, wc, fr, fq);
        if (!has_next) break;
#pragma unroll
        for (int a = 0; a < 2; ++a)
#pragma unroll
            for (int b = 0; b < 2; ++b)
#pragma unroll
                for (int m = 0; m < 4; ++m)
#pragma unroll
                    for (int n = 0; n < 2; ++n) acc[a][b][m][n] = (f32x4){0.f, 0.f, 0.f, 0.f};
        cur = nxt; cA = nA; cB = nB; ++ui;
        if (wr == 1) PG8_BAR;
    }
    PG8_WAIT_V(0);
    PG8_BAR;
#undef PG8_SA
#undef PG8_SB
#undef PG8_STAGE
#undef PG8_LDA
#undef PG8_LDB
#undef PG8_MMA
#undef PG8_WAIT_V
#undef PG8_WAIT_L
#undef PG8_BAR
#undef PG8_SCHED
}
}

struct TrSeg { const float* W; int ldw, ncols, K; bf16_t* WT; int ldt, row_off, mode; const float* gain; };
__device__ __forceinline__ void tr_item(const TrSeg& s, int kb, int nb, LAS float* scr, int lane) {
    const int k0 = 64 * kb, n0 = 64 * nb;
    const int c4 = (lane & 15) * 4, kq = lane >> 4;
    const bool okc = (n0 + c4) < s.ncols;
    const float* src = s.W + (size_t)(k0 + kq) * s.ldw + n0 + c4;
    f32x4 v[16];
#pragma unroll
    for (int i = 0; i < 16; ++i) v[i] = okc ? __builtin_nontemporal_load((const f32x4*)(src + (size_t)(4 * i) * s.ldw)) : (f32x4){0.f, 0.f, 0.f, 0.f};
    if (s.gain) {
#pragma unroll
        for (int i = 0; i < 16; ++i) v[i] = v[i] * s.gain[k0 + 4 * i + kq]; }
#pragma unroll
    for (int i = 0; i < 16; ++i) { LAS float* d = scr + (4 * i + kq) * 65 + c4; d[0] = v[i][0]; d[1] = v[i][1]; d[2] = v[i][2]; d[3] = v[i][3]; }
    asm volatile("s_waitcnt lgkmcnt(0)" ::: "memory");
    const int c = lane & 7;
#pragma unroll
    for (int j = 0; j < 8; ++j) { const int n = (lane >> 3) + 8 * j, gn = n0 + n; const LAS float* sp = scr + (8 * c) * 65 + n;
        u32x4 o; o.x = pk2(sp[0 * 65], sp[1 * 65]); o.y = pk2(sp[2 * 65], sp[3 * 65]); o.z = pk2(sp[4 * 65], sp[5 * 65]); o.w = pk2(sp[6 * 65], sp[7 * 65]);
        const int row = s.mode ? (8 * (gn >> 2) + (gn & 3) + s.row_off) : (s.row_off + gn);
        if (gn < s.ncols) *(u32x4*)(s.WT + (size_t)row * s.ldt + k0 + 8 * c) = o; }
    asm volatile("s_waitcnt lgkmcnt(0)" ::: "memory");
}
__device__ __forceinline__ void tr_run(const TrSeg& s, int& next, int& base, int NGW, LAS float* scr, int lane) {
    const int nnb = (s.ncols + 63) >> 6, n = (s.K >> 6) * nnb;
    while (next < base + n) { const int it = next - base; tr_item(s, it / nnb, it % nnb, scr, lane); next += NGW; }
    base += n;
}
__device__ __forceinline__ void prologue_phase(const Params& p, const Ctx& cx, LAS unsigned char* lds) {
    const int wave = cx.wave, lane = cx.lane, G = cx.G, gw = cx.bid * 8 + wave, NGW = G * 8;
    LAS float* scr = (LAS float*)(lds + wave * 16640);
    unsigned char* ws = cx.ws;
    int next = gw, base = 0;
    for (int j = 0; j < 2; ++j) {
        const float* w_in = p.in[4] + (size_t)j * D * 6160;
        const float* gmix = p.in[1] + (size_t)(2 * j) * D;
        bf16_t* WinA = (bf16_t*)(ws + WS_W + j * GLA_STRIDE + GLA_WINA); bf16_t* Wv = (bf16_t*)(ws + WS_W + j * GLA_STRIDE + GLA_WV); bf16_t* Wo = (bf16_t*)(ws + WS_W + j * GLA_STRIDE + GLA_WOUT);
        { TrSeg s{w_in, 6160, 2048, D, WinA, D, 0, 0, gmix}; tr_run(s, next, base, NGW, scr, lane); }
        { TrSeg s{w_in + 2048, 6160, 2048, D, Wv, D, 0, 0, gmix}; tr_run(s, next, base, NGW, scr, lane); }
        { TrSeg s{w_in + 4096, 6160, 2048, D, WinA, D, 2048, 0, gmix}; tr_run(s, next, base, NGW, scr, lane); }
        { TrSeg s{w_in + 6144, 6160, 16, D, WinA, D, 4096, 0, gmix}; tr_run(s, next, base, NGW, scr, lane); }
        { TrSeg s{p.in[8] + (size_t)j * D * D, D, D, D, Wo, D, 0, 0, nullptr}; tr_run(s, next, base, NGW, scr, lane); }
    }
    for (int j = 0; j < 2; ++j) {
        bf16_t* Win = (bf16_t*)(ws + DSA_BASE + j * DSA_STRIDE + DSA_WIN); bf16_t* Wuv = (bf16_t*)(ws + DSA_BASE + j * DSA_STRIDE + DSA_WUV); bf16_t* Wo = (bf16_t*)(ws + DSA_BASE + j * DSA_STRIDE + DSA_WOUT);
        { TrSeg s{p.in[9] + (size_t)j * D * 6544, 6544, 6544, D, Win, D, 0, 0, p.in[1] + (size_t)(2 * j + 1) * D}; tr_run(s, next, base, NGW, scr, lane); }
        for (int h = 0; h < 16; ++h) {
            TrSeg s{p.in[12] + (size_t)(j * 16 + h) * 256 * 128, 128, 128, 256, Wuv + (size_t)((h >> 1) * 256 + (h & 1) * 128) * 512 + (h & 1) * 256, 512, 0, 0, nullptr};
            tr_run(s, next, base, NGW, scr, lane);
        }
        { TrSeg s{p.in[13] + (size_t)j * D * D, D, D, D, Wo, D, 0, 0, nullptr}; tr_run(s, next, base, NGW, scr, lane); }
        for (int i = cx.bid * 512 + cx.tid; i < 65536; i += G * 512) {
            const int blk = i >> 12, r = (i >> 5) & 127, ch = i & 31, pn = blk >> 1, hh = blk & 1;
            *(u32x4*)(Wuv + (size_t)(pn * 256 + hh * 128 + r) * 512 + (1 - hh) * 256 + ch * 8) = (u32x4){0u, 0u, 0u, 0u};
        }
    }
    for (int i = 0; i < 4; ++i) {
        bf16_t* W13 = (bf16_t*)(ws + FFN_BASE + i * FFN_STRIDE + FFN_W13); bf16_t* W2 = (bf16_t*)(ws + FFN_BASE + i * FFN_STRIDE + FFN_W2);
        { TrSeg s{p.in[15] + (size_t)i * D * FF, FF, FF, D, W13, D, 0, 1, p.in[2] + (size_t)i * D}; tr_run(s, next, base, NGW, scr, lane); }
        { TrSeg s{p.in[16] + (size_t)i * D * FF, FF, FF, D, W13, D, 4, 1, p.in[2] + (size_t)i * D}; tr_run(s, next, base, NGW, scr, lane); }
        { TrSeg s{p.in[17] + (size_t)i * FF * D, D, D, FF, W2, FF, 0, 0, nullptr}; tr_run(s, next, base, NGW, scr, lane); }
    }
    bf16_t* XR = (bf16_t*)(ws + WS_XR); float* RS = (float*)(ws + WS_RSTD);
    for (int m = gw; m < M; m += NGW) {
        const f32x4* xr = (const f32x4*)(p.in[0] + (size_t)m * D) + lane; u32x2* o = (u32x2*)(XR + (size_t)m * D) + lane; float sq = 0.f;
#pragma unroll
        for (int jq = 0; jq < 8; ++jq) { const f32x4 v = __builtin_nontemporal_load(xr + 64 * jq); sq += (v[0] * v[0] + v[1] * v[1]) + (v[2] * v[2] + v[3] * v[3]); u32x2 w; w.x = pk2(v[0], v[1]); w.y = pk2(v[2], v[3]); o[64 * jq] = w; }
        sq = wave_sum(sq);
        if (lane == 0) RS[m] = 1.0f / sqrtf(sq * (1.0f / D) + RMS_EPS);
    }
}

template <bool BF16IN, bool F32OUT>
__device__ __forceinline__ void rms_phase(const void* xp, const float* g, void* outp, const Ctx& cx) {
    const int lane = cx.lane, gw = cx.bid * 8 + cx.wave, NGW = cx.G * 8;
    f32x4 gv[8], nx[8];
#pragma unroll
    for (int j = 0; j < 8; ++j) gv[j] = ((const f32x4*)g)[lane + 64 * j];
#define RMS_LOAD(ROW) do { if (BF16IN) { const u32x2* xr_ = (const u32x2*)((const bf16_t*)xp + (size_t)(ROW) * D) + lane; \
            _Pragma("unroll") for (int j = 0; j < 8; ++j) { const u32x2 t_ = xr_[64 * j]; nx[j] = (f32x4){bflo(t_.x), bfhi(t_.x), bflo(t_.y), bfhi(t_.y)}; } } \
        else { const f32x4* xr_ = (const f32x4*)((const float*)xp + (size_t)(ROW) * D) + lane; _Pragma("unroll") for (int j = 0; j < 8; ++j) nx[j] = xr_[64 * j]; } } while (0)
    if (gw < M) RMS_LOAD(gw);
    for (int m = gw; m < M; m += NGW) {
        f32x4 v[8]; float s = 0.f;
#pragma unroll
        for (int j = 0; j < 8; ++j) v[j] = nx[j];
        if (m + NGW < M) RMS_LOAD(m + NGW);
#pragma unroll
        for (int j = 0; j < 8; ++j) s += (v[j][0] * v[j][0] + v[j][1] * v[j][1]) + (v[j][2] * v[j][2] + v[j][3] * v[j][3]);
        s = wave_sum(s);
        const float r = 1.0f / sqrtf(s * (1.0f / D) + RMS_EPS);
        if (F32OUT) { f32x4* o = (f32x4*)((float*)outp + (size_t)m * D) + lane;
#pragma unroll
            for (int j = 0; j < 8; ++j) o[64 * j] = v[j] * r * gv[j];
        } else { u32x2* o = (u32x2*)((bf16_t*)outp + (size_t)m * D) + lane;
#pragma unroll
            for (int j = 0; j < 8; ++j) { const f32x4 y = v[j] * r * gv[j]; u32x2 w; w.x = pk2(y[0], y[1]); w.y = pk2(y[2], y[3]); o[64 * j] = w; } }
    }
#undef RMS_LOAD
}
__device__ __forceinline__ void rstd_phase(const Ctx& cx) {
    const float* SS = (const float*)(cx.ws + WS_SS); float* RS = (float*)(cx.ws + WS_RSTD);
    for (int m = cx.bid * 512 + cx.tid; m < M; m += cx.G * 512) {
        const f32x4* sp = (const f32x4*)(SS + (size_t)m * 32); float t = 0.f;
#pragma unroll
        for (int q = 0; q < 8; ++q) { const f32x4 a = sp[q]; t += (a[0] + a[1]) + (a[2] + a[3]); }
        RS[m] = 1.0f / sqrtf(t * (1.0f / D) + RMS_EPS);
    }
}
__device__ __forceinline__ float fexp(float x) { return __builtin_amdgcn_exp2f(x * 1.44269504089f); }
__device__ __forceinline__ float log_sigmoid(float z) { return fminf(z, 0.f) - __builtin_amdgcn_logf(1.0f + fexp(-fabsf(z))) * 0.69314718056f; }
__device__ __forceinline__ void gla_gate_phase(const Params& p, const Ctx& cx, int j, LAS unsigned char* lds) {
    const bf16_t* P1 = (const bf16_t*)(cx.ws + WS_P); bf16_t* KDT = (bf16_t*)(cx.ws + WS_KDT); float* DEC = (float*)(cx.ws + WS_DEC);
    const bf16_t* H = (const bf16_t*)(cx.ws + WS_XR); const float* RS = (const float*)(cx.ws + WS_RSTD); const bf16_t* Wa = (const bf16_t*)(cx.ws + WS_W + (size_t)j * GLA_STRIDE + GLA_WINA) + (size_t)4096 * D;
    const float* w_a2 = p.in[5] + (size_t)j * 16 * 1024; const float* b_a = p.in[6] + (size_t)j * 1024;
    const int wave = cx.wave, lane = cx.lane, fr = lane & 15, fq = lane >> 4;
    LAS float* al = (LAS float*)(lds + 32768);
    for (int it = cx.bid; it < 512; it += cx.G) {
        const int bc = it >> 1, kcol = (it & 1) * 512 + cx.tid, b = bc >> 6, c = bc & 63, tok0 = b * T + c * 64;
        __syncthreads();
        {
            f32x4 acc[4];
#pragma unroll
            for (int tt = 0; tt < 4; ++tt) acc[tt] = (f32x4){0.f, 0.f, 0.f, 0.f};
            const bf16_t* hp = H + (size_t)(tok0 + fr) * D + 256 * wave + 8 * fq;
            const bf16_t* wp = Wa + (size_t)fr * D + 256 * wave + 8 * fq;
#pragma unroll
            for (int ss = 0; ss < 8; ++ss) { const bf16x8 bfg = *(const bf16x8*)(wp + 32 * ss);
#pragma unroll
                for (int tt = 0; tt < 4; ++tt) { const bf16x8 afg = *(const bf16x8*)(hp + (size_t)(16 * tt) * D + 32 * ss); acc[tt] = mfma16(afg, bfg, acc[tt]); } }
#pragma unroll
            for (int tt = 0; tt < 4; ++tt) *(LAS f32x4*)(lds + ((wave * 4 + tt) * 64 + lane) * 16) = acc[tt];
        }
        __syncthreads();
        if (cx.tid < 256) { const int tt = cx.tid >> 6, l2 = cx.tid & 63;
            f32x4 v = *(const LAS f32x4*)(lds + (tt * 64 + l2) * 16);
#pragma unroll
            for (int w8 = 1; w8 < 8; ++w8) v = v + *(const LAS f32x4*)(lds + ((w8 * 4 + tt) * 64 + l2) * 16);
            const int tokl = 16 * tt + 4 * (l2 >> 4), r = l2 & 15;
            const f32x4 rq = *(const f32x4*)(RS + tok0 + tokl);
#pragma unroll
            for (int i = 0; i < 4; ++i) al[(tokl + i) * 16 + r] = v[i] * rq[i]; }
        __syncthreads();
        float w[16];
#pragma unroll
        for (int r = 0; r < 16; ++r) w[r] = w_a2[r * 1024 + kcol];
        const float bias = b_a[kcol];
        float cum = 0.f;
        for (int t = 0; t < 64; ++t) {
            const LAS f32x4* ap = (const LAS f32x4*)(al + t * 16); const f32x4 a0 = ap[0], a1 = ap[1], a2 = ap[2], a3 = ap[3];
            float z = bias;
#pragma unroll
            for (int r = 0; r < 4; ++r) { z += a0[r] * w[r] + a1[r] * w[4 + r]; z += a2[r] * w[8 + r] + a3[r] * w[12 + r]; }
            cum += log_sigmoid(z) * (1.0f / 16.0f);
        }
        const float ltot = cum; cum = 0.f;
        for (int t8 = 0; t8 < 8; ++t8) {
            float kd[8];
#pragma unroll
            for (int e = 0; e < 8; ++e) {
                const int t = 8 * t8 + e;
                const LAS f32x4* ap = (const LAS f32x4*)(al + t * 16); const f32x4 a0 = ap[0], a1 = ap[1], a2 = ap[2], a3 = ap[3];
                float z = bias;
#pragma unroll
                for (int r = 0; r < 4; ++r) { z += a0[r] * w[r] + a1[r] * w[4 + r]; z += a2[r] * w[8 + r] + a3[r] * w[12 + r]; }
                cum += log_sigmoid(z) * (1.0f / 16.0f);
                kd[e] = bf2f(P1[(size_t)(tok0 + t) * P1_LD + P1_K + kcol]) * fexp(ltot - cum) * RS[tok0 + t];
            }
            u32x4 o; o.x = pk2(kd[0], kd[1]); o.y = pk2(kd[2], kd[3]); o.z = pk2(kd[4], kd[5]); o.w = pk2(kd[6], kd[7]);
            *(u32x4*)(KDT + (size_t)kcol * M + tok0 + 8 * t8) = o;
        }
        DEC[(size_t)bc * 1024 + kcol] = fexp(ltot);
    }
}

constexpr int SC_KDB = 144, SC_QB = 528, SC_KD_BYTES = 256 * SC_KDB, SC_DEC_OFF = SC_KD_BYTES + 64 * SC_QB, SC_BUF = SC_DEC_OFF + 1024, SC_PART = SC_BUF;
__device__ __forceinline__ void gla_scan_phase(const Params& p, const Ctx& cx, LAS unsigned char* lds) {
    const bf16_t* P1 = (const bf16_t*)(cx.ws + WS_P); const bf16_t* VT = (const bf16_t*)(cx.ws + WS_VT); const bf16_t* KDT = (const bf16_t*)(cx.ws + WS_KDT);
    const float* DEC = (const float*)(cx.ws + WS_DEC); bf16_t* O = (bf16_t*)(cx.ws + WS_O);
    const int tid = cx.tid, wave = cx.wave, lane = cx.lane, G = cx.G, fr = lane & 15, fq = lane >> 4;
    const int vt = wave & 1, kq = wave >> 1;
    for (int item = cx.bid; item < 256; item += G) {
        int bh, vg; if (G == 256) { const int r_ = item >> 3; bh = (item & 7) + 8 * (r_ >> 4); vg = r_ & 15; } else { bh = item >> 4; vg = item & 15; }
        const int b = bh >> 2, h = bh & 3, v0 = vg * 32 + vt * 16;
        const bf16_t* gk = KDT + (size_t)(h * 256 + (tid >> 3)) * M + b * T + (tid & 7) * 8;
        const bf16_t* gq = P1 + (size_t)(b * T + (tid >> 5)) * P1_LD + P1_Q + h * 256 + (tid & 31) * 8;
        const float* gd = DEC + (size_t)(b * 64) * 1024 + h * 256 + (tid & 63) * 4;
        const int lk = (tid >> 3) * SC_KDB + (tid & 7) * 16, lq = SC_KD_BYTES + (tid >> 5) * SC_QB + (tid & 31) * 16;
        u32x4 pk[4], pq[4]; f32x4 pd = (f32x4){0.f, 0.f, 0.f, 0.f};
        __syncthreads();
#pragma unroll
        for (int i = 0; i < 4; ++i) { pk[i] = *(const u32x4*)(gk + (size_t)i * 64 * M); pq[i] = *(const u32x4*)(gq + (size_t)i * 16 * P1_LD); }
        if (tid < 64) pd = *(const f32x4*)gd;
#pragma unroll
        for (int i = 0; i < 4; ++i) { *(LAS u32x4*)(lds + lk + i * 64 * SC_KDB) = pk[i]; *(LAS u32x4*)(lds + lq + i * 16 * SC_QB) = pq[i]; }
        if (tid < 64) *(LAS f32x4*)(lds + SC_DEC_OFF + tid * 16) = pd;
        __syncthreads();
        f32x4 S[4];
#pragma unroll
        for (int i = 0; i < 4; ++i) S[i] = (f32x4){0.f, 0.f, 0.f, 0.f};
        const bf16_t* vtrow = VT + (size_t)(h * 512 + v0 + fr) * M + b * T + 8 * fq;
        bf16x8 nv0 = *(const bf16x8*)vtrow, nv1 = *(const bf16x8*)(vtrow + 32);
        const LAS unsigned char* kdb = lds + (64 * kq + fr) * SC_KDB + 16 * fq;
        const LAS unsigned char* decl = lds + SC_DEC_OFF + 256 * kq + 16 * fq;
        const LAS unsigned char* qb = lds + SC_KD_BYTES + fr * SC_QB + 128 * kq + 8 * fq;
        LAS unsigned char* pw = lds + SC_PART + wave * 4096 + lane * 16;
        const LAS unsigned char* pr = lds + SC_PART + vt * 4096 + kq * 1024 + lane * 16;
        for (int c = 0; c < 64; ++c) {
            const int tokc = c * 64;
            const bf16x8 vf0 = nv0, vf1 = nv1;
            if (c + 1 < 64) {
#pragma unroll
                for (int i = 0; i < 4; ++i) { pk[i] = *(const u32x4*)(gk + (size_t)i * 64 * M + tokc + 64); pq[i] = *(const u32x4*)(gq + (size_t)i * 16 * P1_LD + (size_t)(tokc + 64) * P1_LD); }
                nv0 = *(const bf16x8*)(vtrow + tokc + 64); nv1 = *(const bf16x8*)(vtrow + tokc + 96); if (tid < 64) pd = *(const f32x4*)(gd + (size_t)(c + 1) * 1024);
            }
#pragma unroll
            for (int j = 0; j < 4; ++j) {
                const f32x4 d = *(const LAS f32x4*)(decl + 64 * j);
                const bf16x8 a0 = *(const LAS bf16x8*)(kdb + j * 16 * SC_KDB), a1 = *(const LAS bf16x8*)(kdb + j * 16 * SC_KDB + 64);
                f32x4 sv = S[j] * d;
                sv = mfma16(a0, vf0, sv); sv = mfma16(a1, vf1, sv); S[j] = sv;
            }
            bf16x8 sf[2];
#pragma unroll
            for (int ks = 0; ks < 2; ++ks) { u32x4 w; w.x = pk2(S[2 * ks][0], S[2 * ks][1]); w.y = pk2(S[2 * ks][2], S[2 * ks][3]); w.z = pk2(S[2 * ks + 1][0], S[2 * ks + 1][1]); w.w = pk2(S[2 * ks + 1][2], S[2 * ks + 1][3]);
                sf[ks] = __builtin_bit_cast(bf16x8, w); }
#pragma unroll
            for (int ct = 0; ct < 4; ++ct) {
                f32x4 o = (f32x4){0.f, 0.f, 0.f, 0.f};
#pragma unroll
                for (int ks = 0; ks < 2; ++ks) {
                    const u32x2 q0 = *(const LAS u32x2*)(qb + ct * 16 * SC_QB + 64 * ks), q1 = *(const LAS u32x2*)(qb + ct * 16 * SC_QB + 64 * ks + 32);
                    u32x4 qw; qw.x = q0.x; qw.y = q0.y; qw.z = q1.x; qw.w = q1.y;
                    o = mfma16(sf[ks], __builtin_bit_cast(bf16x8, qw), o);
                }
                *(LAS f32x4*)(pw + ct * 1024) = o;
            }
            __syncthreads();
            {
                f32x4 o = *(const LAS f32x4*)pr;
#pragma unroll
                for (int k2 = 1; k2 < 4; ++k2) o = o + *(const LAS f32x4*)(pr + k2 * 8192);
                u32x2 w; w.x = pk2(o[0] * 0.0625f, o[1] * 0.0625f); w.y = pk2(o[2] * 0.0625f, o[3] * 0.0625f);
                *(u32x2*)(O + (size_t)(b * T + tokc + 16 * kq + fr) * D + h * 512 + v0 + 4 * fq) = w;
            }
            if (c + 1 < 64) {
#pragma unroll
                for (int i = 0; i < 4; ++i) { *(LAS u32x4*)(lds + lk + i * 64 * SC_KDB) = pk[i]; *(LAS u32x4*)(lds + lq + i * 16 * SC_QB) = pq[i]; }
                if (tid < 64) *(LAS f32x4*)(lds + SC_DEC_OFF + tid * 16) = pd;
            }
            __syncthreads();
        }
    }
}

__device__ __forceinline__ void gla_normgate_phase(const Params& p, const Ctx& cx, int j) {
    const int wave = cx.wave, lane = cx.lane;
    const bf16_t* P1 = (const bf16_t*)(cx.ws + WS_P); const bf16_t* O = (const bf16_t*)(cx.ws + WS_O); bf16_t* A2 = (bf16_t*)(cx.ws + WS_H);
    const float* gn = p.in[7] + (size_t)j * 512 + lane * 8;
    const f32x4 g0 = *(const f32x4*)gn, g1 = *(const f32x4*)(gn + 4);
    const int gw = cx.bid * 8 + wave, NGW = cx.G * 8;
    u32x4 no[4], ng[4];
    if (gw < M) {
#pragma unroll
        for (int h = 0; h < 4; ++h) { no[h] = *(const u32x4*)(O + (size_t)gw * D + h * 512 + lane * 8); ng[h] = *(const u32x4*)(P1 + (size_t)gw * P1_LD + P1_G + h * 512 + lane * 8); }
    }
    for (int tok = gw; tok < M; tok += NGW) {
        u32x4 ovv[4], gvv[4];
#pragma unroll
        for (int h = 0; h < 4; ++h) { ovv[h] = no[h]; gvv[h] = ng[h]; }
        if (tok + NGW < M) {
#pragma unroll
            for (int h = 0; h < 4; ++h) { no[h] = *(const u32x4*)(O + (size_t)(tok + NGW) * D + h * 512 + lane * 8); ng[h] = *(const u32x4*)(P1 + (size_t)(tok + NGW) * P1_LD + P1_G + h * 512 + lane * 8); }
        }
#pragma unroll
        for (int h = 0; h < 4; ++h) {
            const u32x4 ov = ovv[h], gv = gvv[h];
            float v[8], g[8];
#pragma unroll
            for (int i = 0; i < 4; ++i) { v[2 * i] = bflo(ov[i]); v[2 * i + 1] = bfhi(ov[i]); g[2 * i] = bflo(gv[i]); g[2 * i + 1] = bfhi(gv[i]); }
            float ss = 0.f;
#pragma unroll
            for (int i = 0; i < 8; ++i) ss += v[i] * v[i];
            ss = wave_sum(ss);
            const float r = __builtin_amdgcn_rsqf(ss * (1.0f / 512.0f) + RMS_EPS);
            float y[8];
#pragma unroll
            for (int i = 0; i < 8; ++i) { const float gg = (i < 4) ? g0[i] : g1[i - 4]; y[i] = v[i] * r * gg * (g[i] * __builtin_amdgcn_rcpf(1.0f + fexp(-g[i]))); }
            u32x4 w; w.x = pk2(y[0], y[1]); w.y = pk2(y[2], y[3]); w.z = pk2(y[4], y[5]); w.w = pk2(y[6], y[7]);
            *(u32x4*)(A2 + (size_t)tok * D + h * 512 + lane * 8) = w;
        }
    }
}

__device__ __forceinline__ void dsa_post_phase(const Params& p, const Ctx& cx, int j) {
    const int wave = cx.wave, lane = cx.lane;
    const bf16_t* P2 = (const bf16_t*)(cx.ws + WS_P); bf16_t* CN = (bf16_t*)(cx.ws + WS_CN); bf16_t* KI = (bf16_t*)(cx.ws + WS_KI); float* WI = (float*)(cx.ws + WS_WI);
    const f32x4 kvn = *(const f32x4*)(p.in[10] + (size_t)j * 256 + lane * 4);
    const float kn0 = p.in[11][(size_t)j * 128 + lane * 2], kn1 = p.in[11][(size_t)j * 128 + lane * 2 + 1];
    const int gw = cx.bid * 8 + wave, NGW = cx.G * 8;
    for (int m = gw; m < M; m += NGW) {
        const bf16_t* row = P2 + (size_t)m * P2_LD;
        const u32x2 cv = *(const u32x2*)(row + P2_C + lane * 4);
        const float c0 = bflo(cv.x), c1 = bfhi(cv.x), c2 = bflo(cv.y), c3 = bfhi(cv.y);
        float ss = wave_sum((c0 * c0 + c1 * c1) + (c2 * c2 + c3 * c3));
        float r = 1.0f / sqrtf(ss * (1.0f / 256.0f) + RMS_EPS);
        u32x2 w; w.x = pk2(c0 * r * kvn[0], c1 * r * kvn[1]); w.y = pk2(c2 * r * kvn[2], c3 * r * kvn[3]);
        *(u32x2*)(CN + (size_t)m * 256 + lane * 4) = w;
        const unsigned kv = *(const unsigned*)(row + P2_KI + lane * 2);
        const float k0 = bflo(kv), k1 = bfhi(kv);
        ss = wave_sum(k0 * k0 + k1 * k1);
        r = 1.0f / sqrtf(ss * (1.0f / 128.0f) + RMS_EPS);
        *(unsigned*)(KI + (size_t)m * 128 + lane * 2) = pk2(k0 * r * kn0, k1 * r * kn1);
        if (lane < 16) WI[(size_t)m * 16 + lane] = bf2f(row[P2_WI + lane]) * (0.25f * 0.08838834764831845f);
    }
}

__device__ __forceinline__ void dsa_index_phase(const Params& p, const Ctx& cx, LAS unsigned char* lds) {
    const int wave = cx.wave, lane = cx.lane;
    const bf16_t* P2 = (const bf16_t*)(cx.ws + WS_P); const bf16_t* KI = (const bf16_t*)(cx.ws + WS_KI); const float* WI = (const float*)(cx.ws + WS_WI); int* IDX = (int*)(cx.ws + WS_IDX);
    const int G = cx.G;
    const int pair = wave >> 1, kh = wave & 1, rho = lane & 31, hA = lane >> 5;
    for (int k = 0;; ++k) {
        const int it = cx.bid + k * G; if (it >= 2048) break;
        int b, pos; if (G == 256) { b = k >> 1; pos = (k & 1) ? 511 - cx.bid : cx.bid; } else { b = it >> 9; pos = it & 511; }
        const int q0 = pos * 8, nch = (q0 >> 6) + 1, ntile = 2 * nch;
        {
            const int qA = q0 + 2 * pair + ((rho >> 2) & 1), headA = (rho & 3) + 4 * (rho >> 3);
            const bf16_t* qip = P2 + (size_t)(b * T + qA) * P2_LD + P2_QI + headA * 128 + 8 * hA;
            bf16x8 af[8];
#pragma unroll
            for (int s = 0; s < 8; ++s) af[s] = *(const bf16x8*)(qip + 16 * s);
            const float* wp = WI + (size_t)(b * T + q0 + 2 * pair + hA) * 16;
            f32x4 w4[4];
#pragma unroll
            for (int i = 0; i < 4; ++i) w4[i] = *(const f32x4*)(wp + 4 * i);
            LAS float* sc = (LAS float*)lds + (2 * pair + hA) * 4096;
            LAS unsigned char* stg = lds + 131072;
            const char* kub = (const char*)(KI + (size_t)(b * T) * 128);
            const unsigned kvo = (unsigned)(((cx.tid >> 4) * 128 + (cx.tid & 15) * 8) * 2);
#define KLD(TILE, HALF_) (*(const u32x4*)(kub + (size_t)(TILE) * 16384 + (size_t)(HALF_) * 8192 + kvo))
            const int sto = (cx.tid >> 4) * 272 + (cx.tid & 15) * 16;
            __builtin_amdgcn_s_waitcnt(0);
            u32x4 rA0 = KLD(0, 0), rA1 = KLD(0, 1), rB0 = rA0, rB1 = rA1;
            if (nch > 1) { rB0 = KLD(1, 0); rB1 = KLD(1, 1); }
            const LAS unsigned char* brd = stg + (kh * 32 + rho) * 272 + 16 * hA;
#define IDX_TILE(R0, R1, TILE) do { \
                __syncthreads(); \
                *(LAS u32x4*)(stg + sto) = R0; *(LAS u32x4*)(stg + sto + 32 * 272) = R1; \
                __syncthreads(); \
                if ((TILE) + 2 < nch) { R0 = KLD((TILE) + 2, 0); R1 = KLD((TILE) + 2, 1); } \
                bf16x8 bfr[8]; \
                _Pragma("unroll") for (int s = 0; s < 8; ++s) bfr[s] = *(const LAS bf16x8*)(brd + 32 * s); \
                f32x16 acc, acc2; \
                _Pragma("unroll") for (int i = 0; i < 16; ++i) { acc[i] = 0.f; acc2[i] = 0.f; } \
                _Pragma("unroll") for (int s = 0; s < 4; ++s) { acc = mfma32(af[2 * s], bfr[2 * s], acc); acc2 = mfma32(af[2 * s + 1], bfr[2 * s + 1], acc2); } \
                float v = 0.f, v2 = 0.f; \
                _Pragma("unroll") for (int i = 0; i < 16; i += 2) { v += w4[i >> 2][i & 3] * fmaxf(acc[i] + acc2[i], 0.f); v2 += w4[(i + 1) >> 2][(i + 1) & 3] * fmaxf(acc[i + 1] + acc2[i + 1], 0.f); } \
                v += v2; \
                sc[(TILE) * 64 + kh * 32 + rho] = v; } while (0)
            for (int tile = 0; tile < nch; tile += 2) {
                IDX_TILE(rA0, rA1, tile);
                if (tile + 1 < nch) IDX_TILE(rB0, rB1, tile + 1);
            }
#undef IDX_TILE
#undef KLD
        }
        __syncthreads();
        {
            const LAS unsigned* su = (const LAS unsigned*)lds + wave * 4096 + lane;
            unsigned u[64];
#pragma unroll
            for (int jj = 0; jj < 64; ++jj) { unsigned x = 0u; if (jj < nch) { const float sv_ = __builtin_bit_cast(float, su[jj * 64]);
                    const unsigned bits = (unsigned)__builtin_bit_cast(unsigned short, (_Float16)sv_) << 16; x = (bits & 0x80000000u) ? (~bits & 0xffff0000u) : (bits | 0x80000000u); } u[jj] = x; }
            int* ip = IDX + (size_t)(b * T + q0 + wave) * 256;
            if (nch <= 4) {
#pragma unroll
                for (int jj = 0; jj < 4; ++jj) ip[jj * 64 + lane] = (jj < nch) ? jj * 64 + lane : -1;
            } else {
                unsigned Tt = 0u;
                for (int bit = 31; bit >= 16; --bit) {
                    const unsigned cand = Tt | (1u << bit); int cnt = 0;
#pragma unroll
                    for (int g8 = 0; g8 < 8; ++g8) { if (g8 * 8 < nch) {
#pragma unroll
                        for (int jj = g8 * 8; jj < g8 * 8 + 8; ++jj) cnt += __builtin_popcountll(__ballot(u[jj] >= cand)); } }
                    if (cnt >= 256) Tt = cand;
                    if (cnt == 256) break;
                }
                int basep = 0;
#pragma unroll
                for (int jj = 0; jj < 64; ++jj) { if (jj >= nch) continue; const bool sel = u[jj] > Tt; const unsigned long long mk = __ballot(sel);
                    const int ps = basep + (int)__builtin_amdgcn_mbcnt_hi((unsigned)(mk >> 32), __builtin_amdgcn_mbcnt_lo((unsigned)mk, 0u));
                    if (sel) ip[ps] = jj * 64 + lane; basep += __builtin_popcountll(mk); }
#pragma unroll
                for (int jj = 0; jj < 64; ++jj) { if (jj >= nch) continue; const bool sel = u[jj] == Tt; const unsigned long long mk = __ballot(sel);
                    const int ps = basep + (int)__builtin_amdgcn_mbcnt_hi((unsigned)(mk >> 32), __builtin_amdgcn_mbcnt_lo((unsigned)mk, 0u));
                    if (sel && ps < 256) ip[ps] = jj * 64 + lane; basep += __builtin_popcountll(mk); }
            }
        }
        __syncthreads();
    }
}

constexpr int AT_ROWB = 528, AT_WAVEB = 32 * AT_ROWB, AT_BIAS = 8 * AT_WAVEB;
__device__ __forceinline__ s16x4 ld_tr(const LAS unsigned char* ptr) { return __builtin_bit_cast(s16x4, __builtin_amdgcn_ds_read_tr16_b64_v4i16((LAS s16x4*)ptr)); }
__device__ __forceinline__ int att_tok(const Ctx& cx, int k, int wloc) {
    if (cx.G == 256) return (k < 8) ? ((cx.bid & 7) >> 1) * T + k * 512 + wloc : -1;
    const int tok = cx.bid * 8 + cx.wave + k * cx.G * 8; return tok < M ? tok : -1;
}
#define ATT_GATHER(IR, SBLO, BB) do { const bf16_t* cb_ = CN + (size_t)(BB) * T * 256 + (lane & 31) * 8; _Pragma("unroll") for (int i_ = 0; i_ < 16; ++i_) { const int kidx_ = __shfl((IR), 32 * (SBLO) + 2 * i_ + (lane >> 5)); const unsigned kk_ = kidx_ < 0 ? 0u : (unsigned)kidx_; \
        g[i_] = *(const u32x4*)(cb_ + kk_ * 256u); if ((i_ & 3) == 3) asm volatile("" ::: "memory"); } } while (0)
__device__ __forceinline__ void dsa_attn_phase(const Params& p, const Ctx& cx, LAS unsigned char* lds) {
    const int wave = cx.wave, lane = cx.lane;
    const bf16_t* P2 = (const bf16_t*)(cx.ws + WS_P); const bf16_t* CN = (const bf16_t*)(cx.ws + WS_CN); const int* IDX = (const int*)(cx.ws + WS_IDX); bf16_t* OB = (bf16_t*)(cx.ws + WS_OB);
    LAS float* lb = (LAS float*)(lds + AT_BIAS);
    for (int e_ = cx.tid; e_ < 256 * 16; e_ += 512) { const int rel = (e_ >> 4) - 128, hd = e_ & 15, n = rel < 0 ? -rel : rel;
        const int large = 8 + (n >= 12) + (n >= 16) + (n >= 23) + (n >= 32) + (n >= 46) + (n >= 64) + (n >= 91);
        const int bk = ((rel > 0) ? 16 : 0) + ((n < 8) ? n : large);
        lb[e_] = p.in[14][bk * 16 + hd]; }
    __syncthreads();
    LAS unsigned char* wl = lds + wave * AT_WAVEB;
    const int fr = lane & 15, fq = lane >> 4;
    const int wloc = ((cx.bid & 1) * 32 + (cx.bid >> 3)) * 8 + wave;
    int tok = att_tok(cx, 0, wloc);
    int ir0 = 0, ir1 = 0, ir2 = 0, ir3 = 0;
    u32x4 g[16];
    if (tok >= 0) { const int* ip = IDX + (size_t)tok * 256 + lane; ir0 = ip[0]; ir1 = ip[64]; ir2 = ip[128]; ir3 = ip[192]; }
    for (int k = 0; tok >= 0; ++k) {
        const int b = tok >> 12, t = tok & (T - 1);
        const int ntok = att_tok(cx, k + 1, wloc);
        int nr0 = 0, nr1 = 0, nr2 = 0, nr3 = 0;
        if (ntok >= 0) { const int* ip = IDX + (size_t)ntok * 256 + lane; nr0 = ip[0]; nr1 = ip[64]; nr2 = ip[128]; nr3 = ip[192]; }
        const bf16_t* qp = P2 + (size_t)tok * P2_LD + P2_Q + fr * 256 + 8 * fq;
        float m_run = -INFINITY, l_run = 0.f;
        f32x4 oacc[16];
#pragma unroll
        for (int i = 0; i < 16; ++i) oacc[i] = (f32x4){0.f, 0.f, 0.f, 0.f};
        for (int sb = 0; sb < 8; ++sb) {
            const int h2 = sb >> 1, irc = (h2 == 0) ? ir0 : (h2 == 1) ? ir1 : (h2 == 2) ? ir2 : ir3;
            ATT_GATHER(irc, sb & 1, b);
#pragma unroll
            for (int i = 0; i < 16; ++i) *(LAS u32x4*)(wl + (2 * i + (lane >> 5)) * AT_ROWB + (lane & 31) * 16) = g[i];
            int kx[8];
#pragma unroll
            for (int e = 0; e < 8; ++e) kx[e] = __shfl(irc, 32 * (sb & 1) + 16 * (e >> 2) + 4 * fq + (e & 3));
            bf16x8 qf[8];
            { size_t qo_ = 0; asm volatile("" : "+s"(qo_));
#pragma unroll
              for (int s = 0; s < 8; ++s) qf[s] = *(const bf16x8*)(qp + qo_ + 32 * s); }
            asm volatile("s_waitcnt lgkmcnt(0)" ::: "memory");
            f32x4 sacc[2];
#pragma unroll
            for (int kt2 = 0; kt2 < 2; ++kt2) { f32x4 a = (f32x4){0.f, 0.f, 0.f, 0.f};
#pragma unroll
                for (int s = 0; s < 8; ++s) { const bf16x8 cf = *(const LAS bf16x8*)(wl + (16 * kt2 + fr) * AT_ROWB + (32 * s + 8 * fq) * 2); a = mfma16(cf, qf[s], a); if ((s & 3) == 3) asm volatile("" ::: "memory"); }
                sacc[kt2] = a; }
            float lg[8];
#pragma unroll
            for (int e = 0; e < 8; ++e) { const int kidx = kx[e]; const float a = ((e < 4) ? sacc[0][e & 3] : sacc[1][e & 3]) * 0.0625f;
                int rel = kidx - t; rel = rel < -128 ? -128 : (rel > 127 ? 127 : rel);
                const float bias = lb[(rel + 128) * 16 + fr];
                lg[e] = (kidx < 0) ? -INFINITY : a + bias; }
            float bm = fmaxf(fmaxf(fmaxf(lg[0], lg[1]), fmaxf(lg[2], lg[3])), fmaxf(fmaxf(lg[4], lg[5]), fmaxf(lg[6], lg[7])));
            bm = fmaxf(bm, __shfl_xor(bm, 16)); bm = fmaxf(bm, __shfl_xor(bm, 32));
            const float m_new = fmaxf(m_run, bm), scale = __expf(m_run - m_new);
            float pe[8], psum = 0.f;
#pragma unroll
            for (int e = 0; e < 8; ++e) { pe[e] = __expf(lg[e] - m_new); psum += pe[e]; }
            l_run = l_run * scale + psum; m_run = m_new;
#pragma unroll
            for (int i = 0; i < 16; ++i) oacc[i] = oacc[i] * scale;
            u32x4 pw; pw.x = pk2(pe[0], pe[1]); pw.y = pk2(pe[2], pe[3]); pw.z = pk2(pe[4], pe[5]); pw.w = pk2(pe[6], pe[7]);
            const bf16x8 pf = __builtin_bit_cast(bf16x8, pw);
            const LAS unsigned char* tb = wl + (4 * fq + ((lane & 15) >> 2)) * AT_ROWB + 8 * (lane & 3);
#pragma unroll
            for (int lt = 0; lt < 16; ++lt) {
                const s16x4 t0 = ld_tr(tb + 32 * lt), t1 = ld_tr(tb + 16 * AT_ROWB + 32 * lt);
                bf16x8 cf; cf[0] = t0[0]; cf[1] = t0[1]; cf[2] = t0[2]; cf[3] = t0[3]; cf[4] = t1[0]; cf[5] = t1[1]; cf[6] = t1[2]; cf[7] = t1[3];
                oacc[lt] = mfma16(cf, pf, oacc[lt]);
                if ((lt & 3) == 3) asm volatile("" ::: "memory");
            }
            asm volatile("s_waitcnt lgkmcnt(0)" ::: "memory");
        }
        float lt_ = l_run + __shfl_xor(l_run, 16); lt_ += __shfl_xor(lt_, 32);
        const float inv = 1.0f / lt_;
        bf16_t* op = OB + (size_t)tok * 4096 + fr * 256 + 4 * fq;
#pragma unroll
        for (int lt = 0; lt < 16; ++lt) { u32x2 w; w.x = pk2(oacc[lt][0] * inv, oacc[lt][1] * inv); w.y = pk2(oacc[lt][2] * inv, oacc[lt][3] * inv); *(u32x2*)(op + 16 * lt) = w; }
        tok = ntok; ir0 = nr0; ir1 = nr1; ir2 = nr2; ir3 = nr3;
    }
    __syncthreads();
}

#define XB_TMO      128
#define XB_XCNT(j)  (256  + 64 * (j))
#define XB_XSUB(j)  (1280 + 64 * (j))
#define XB_XGEN(j)  (2304 + 64 * (j))
#define XB_TOP      3328
#define XB_TOPGEN   3392
#define XCD_BAR_WORDS 3456
#define XB_SPIN_CAP (1u << 22)
__device__ __forceinline__ unsigned xb_ld(unsigned* p)              { return __hip_atomic_load(p, __ATOMIC_RELAXED, __HIP_MEMORY_SCOPE_AGENT); }
__device__ __forceinline__ unsigned xb_add(unsigned* p, unsigned v) { return __hip_atomic_fetch_add(p, v, __ATOMIC_RELAXED, __HIP_MEMORY_SCOPE_AGENT); }
__device__ __forceinline__ unsigned xb_xcc_id() { return (unsigned)__builtin_amdgcn_s_getreg((3 << 11) | 20) & 0xFu; }
#define XB_SPIN(cond, bar) do { unsigned _sp = 0; while (cond) { __builtin_amdgcn_s_sleep(1); \
    if ((++_sp & 255u) == 0u) { if (xb_ld(&(bar)[XB_TMO])) break; if (_sp > XB_SPIN_CAP) { atomicAdd(&(bar)[XB_TMO], 1u); break; } } } } while (0)
struct XcdBarrier { unsigned* bar; unsigned x; volatile LAS unsigned* st; };
__device__ __forceinline__ XcdBarrier xcd_barrier_post(unsigned* bar, volatile LAS unsigned* st) {
    XcdBarrier b; b.bar = bar; b.x = xb_xcc_id(); b.st = st;
    if (threadIdx.x == 0) (void)xb_add(&bar[XB_XCNT(b.x)], 1u);
    return b;
}
__device__ __forceinline__ void xcd_barrier_complete(unsigned* bar, unsigned x, unsigned& nloc, unsigned& nx) {
    const unsigned G = gridDim.x * gridDim.y * gridDim.z;
    unsigned sum, cnt, mine, sp = 0u;
    for (;;) {
        sum = 0u; cnt = 0u; mine = 0u;
#pragma unroll
        for (unsigned j = 0; j < 16; ++j) { const unsigned c = xb_ld(&bar[XB_XCNT(j)]); sum += c; cnt += (c > 0u) ? 1u : 0u; mine = (j == x) ? c : mine; }
        if (sum == G) break;
        __builtin_amdgcn_s_sleep(1);
        if ((++sp & 255u) == 0u) { if (xb_ld(&bar[XB_TMO])) break; if (sp > XB_SPIN_CAP) { atomicAdd(&bar[XB_TMO], 1u); break; } }
    }
    nloc = mine > 0u ? mine : 1u; nx = cnt > 0u ? cnt : 1u;
}
__device__ __forceinline__ void xcd_barrier(const XcdBarrier& b) {
    asm volatile("s_waitcnt vmcnt(0)" ::: "memory");
    __syncthreads();
    if (threadIdx.x == 0) {
        unsigned* bar = b.bar;
        __builtin_amdgcn_s_waitcnt(0);
        unsigned nloc = b.st[0], nx = b.st[1];
        if (nloc == 0u) { xcd_barrier_complete(bar, b.x, nloc, nx); b.st[0] = nloc; b.st[1] = nx; }
        const unsigned old = xb_add(&bar[XB_XSUB(b.x)], 1u);
        const unsigned gen = old / nloc;
        if (old + 1u == (gen + 1u) * nloc) {
            __builtin_amdgcn_fence(__ATOMIC_RELEASE, "agent");
            asm volatile("s_waitcnt vmcnt(0)" ::: "memory");
            const unsigned og = xb_add(&bar[XB_TOP], 1u);
            const unsigned tg = og / nx;
            if (og + 1u == (tg + 1u) * nx) xb_add(&bar[XB_TOPGEN], 1u);
            else XB_SPIN(xb_ld(&bar[XB_TOPGEN]) == tg, bar);
            __builtin_amdgcn_fence(__ATOMIC_ACQUIRE, "agent");
            xb_add(&bar[XB_XGEN(b.x)], 1u);
            asm volatile("s_waitcnt vmcnt(0)" ::: "memory");
        } else {
            XB_SPIN(xb_ld(&bar[XB_XGEN(b.x)]) == gen, bar);
            __builtin_amdgcn_fence(__ATOMIC_ACQUIRE, "agent");
            asm volatile("s_waitcnt vmcnt(0)" ::: "memory");
        }
    }
    __syncthreads();
}

constexpr int N_PHASES = 42;
__host__ __device__ inline bool phase_is_nop(int ph) { if (ph == 0 || ph == 41) return false; const int L = (ph - 1) / 10, s = (ph - 1) % 10; return (L == 0 && s == 0) || ((!(L & 1)) && s == 6); }

__host__ __device__ inline int phase_kind(int ph) {
    if (ph == 0) return 0; if (ph == 41) return 1;
    const int L = (ph - 1) / 10, s = (ph - 1) % 10; const bool gla = !(L & 1);
    if (s == 0 || s == 7) return 1; if (s == 1 || (!gla && s == 5)) return 2; if ((gla && s == 5) || (!gla && s == 6) || s == 9) return 3; if (s == 8) return 4;
    if (gla) return 3 + s; return 6 + s;
}
__global__ void __launch_bounds__(512, 2) trunk_fwd(Params p) {
    extern __shared__ __attribute__((aligned(16))) unsigned char smem[];
    LAS unsigned char* lds = (LAS unsigned char*)smem;
    volatile LAS unsigned* bst = (volatile LAS unsigned*)(lds + LDS_CTL);
    if (threadIdx.x < 64) bst[threadIdx.x] = 0u;
    __syncthreads();
    XcdBarrier gbar = xcd_barrier_post((unsigned*)p.ws, bst);
    if (p.ph_lo > 1000) cg::this_grid().sync();
    for (int ph = p.ph_lo, rep_ = 0; ph < p.ph_hi;) {
        if (phase_is_nop(ph)) { ++ph; continue; }
        int b_ = blockIdx.x; asm volatile("" : "+s"(b_)); int g_ = gridDim.x; asm volatile("" : "+s"(g_));
        size_t z_ = 0; asm volatile("" : "+s"(z_)); unsigned char* ws = p.ws + z_;
#define MKCX Ctx cx; { int t_ = threadIdx.x; asm volatile("" : "+v"(t_)); cx.tid = t_; cx.lane = t_ & 63; cx.wave = __builtin_amdgcn_readfirstlane(t_ >> 6); cx.bid = b_; cx.G = g_; cx.ws = ws; }
        bf16_t* Hb = (bf16_t*)(ws + WS_H); bf16_t* Pb = (bf16_t*)(ws + WS_P); bf16_t* XRp = (bf16_t*)(ws + WS_XR); const float* RSk = (const float*)(ws + WS_RSTD);
        if (ph == 0) { if (PHON(0)) { MKCX; prologue_phase(p, cx, lds); } }
        else if (ph == 41) { if (PHON(1)) { MKCX; rms_phase<true, true>(ws + WS_XR, p.in[3], p.out, cx); } }
        else {
            const int L = (ph - 1) / 10, s = (ph - 1) % 10, j = L >> 1; const bool gla = !(L & 1);
            unsigned char* wg = ws + WS_W + j * GLA_STRIDE; unsigned char* wd = ws + DSA_BASE + j * DSA_STRIDE; unsigned char* wf = ws + FFN_BASE + L * FFN_STRIDE;
            if (s == 0) { if (PHON(1)) { MKCX; rstd_phase(cx); } }
            else if (s == 7) { if (PHON(1)) { MKCX; rstd_phase(cx); } }
            else if (s == 1 || (!gla && s == 5)) {
                const int ng = (gla && s == 1) ? 2 : 1;
                for (int gi = 0; gi < ng; ++gi) {
                    pg8::Gemm g; pg8::EpiStore E;
                    if (gla) {
                        if (gi == 0) { g = pg8::Gemm{XRp, (const bf16_t*)(wg + GLA_WINA), M, 4096, D, D, D, 0}; E = pg8::EpiStore{Pb, P1_LD, RSk}; }
                        else { g = pg8::Gemm{(const bf16_t*)(wg + GLA_WV), XRp, D, M, D, D, D, 0}; E = pg8::EpiStore{(bf16_t*)(ws + WS_VT), M, nullptr}; }
                    } else if (s == 1) { g = pg8::Gemm{XRp, (const bf16_t*)(wd + DSA_WIN), M, P2_LD, D, D, D, 0}; E = pg8::EpiStore{Pb, P2_LD, RSk}; }
                    else { g = pg8::Gemm{(const bf16_t*)(ws + WS_OB), (const bf16_t*)(wd + DSA_WUV), M, D, 512, 4096, 512, 512}; E = pg8::EpiStore{Hb, D, nullptr}; }
                    pg8::StaticOrder S; S.init(g.M, g.N, g_, b_); int t2_ = threadIdx.x; asm volatile("" : "+v"(t2_));
                    if (PHON(2)) pg8::gemm_phase(lds, g, S, E, t2_);
                }
            } else if ((gla && s == 5) || (!gla && s == 6) || s == 9) {
                pg8::Gemm g;
                if (s == 9) g = pg8::Gemm{Pb, (const bf16_t*)(wf + FFN_W2), M, D, FF, FF, FF, 0};
                else g = pg8::Gemm{Hb, (const bf16_t*)(gla ? wg + GLA_WOUT : wd + DSA_WOUT), M, D, D, D, D, 0};
                pg8::EpiResid E{XRp, (float*)(ws + WS_SS)};
                pg8::StaticOrder S; S.init(g.M, g.N, g_, b_); int t2_ = threadIdx.x; asm volatile("" : "+v"(t2_));
                if (PHON(3)) pg8::gemm_phase(lds, g, S, E, t2_);
            } else if (s == 8) {
                pg8::Gemm g{XRp, (const bf16_t*)(wf + FFN_W13), M, 2 * FF, D, D, D, 0};
                pg8::EpiSwiglu E{Pb, RSk};
                pg8::StaticOrder S; S.init(g.M, g.N, g_, b_); int t2_ = threadIdx.x; asm volatile("" : "+v"(t2_));
                if (PHON(4)) pg8::gemm_phase(lds, g, S, E, t2_);
            } else if (gla) {
                if (s == 2) { if (PHON(5)) { MKCX; gla_gate_phase(p, cx, j, lds); } }
                else if (s == 3) { if (PHON(6)) { MKCX; gla_scan_phase(p, cx, lds); } }
                else if (s == 4) { if (PHON(7)) { MKCX; gla_normgate_phase(p, cx, j); } }
            } else {
                if (s == 2) { if (PHON(8)) { MKCX; dsa_post_phase(p, cx, j); } }
                else if (s == 3) { if (PHON(9)) { MKCX; dsa_index_phase(p, cx, lds); } }
                else if (s == 4) { if (PHON(10)) { MKCX; dsa_attn_phase(p, cx, lds); } }
            }
        }
        if (ph + 1 < p.ph_hi) { xcd_barrier(gbar); if ((REP_MASK >> 11) & 1) xcd_barrier(gbar); }
        if (REP_MASK && rep_ == 0 && phase_kind(ph) != 3 && ((REP_MASK >> phase_kind(ph)) & 1)) rep_ = 1; else { rep_ = 0; ++ph; }
    }
}

extern "C" void kernel_launch(void* const* d_in, const int* in_sizes, int n_in, void* d_out, int out_size, void* d_ws, size_t ws_size, hipStream_t stream) {
    static int grid = 0;
    if (!grid) {
        if (n_in != 18 || out_size != M * D || ws_size < WS_END) { fprintf(stderr, "kernel_launch: unexpected shapes (n_in %d out %d ws %zu)\n", n_in, out_size, ws_size); grid = -1; return; }
        int dev = 0, cus = 0, per_cu = 0;
        hipGetDevice(&dev); hipDeviceGetAttribute(&cus, hipDeviceAttributeMultiprocessorCount, dev);
        if (hipFuncSetAttribute((const void*)trunk_fwd, hipFuncAttributeMaxDynamicSharedMemorySize, LDS_BYTES) != hipSuccess) { fprintf(stderr, "kernel_launch: hipFuncSetAttribute failed\n"); grid = -1; return; }
        hipOccupancyMaxActiveBlocksPerMultiprocessor(&per_cu, (const void*)trunk_fwd, 512, LDS_BYTES);
        if (per_cu < 1) per_cu = 1;
        grid = cus * per_cu;
        fprintf(stderr, "kernel_launch: grid %d (cus %d x %d)\n", grid, cus, per_cu);
    }
    if (grid < 0) return;
    if (hipMemsetAsync(d_ws, 0, XCD_BAR_WORDS * 4, stream) != hipSuccess) { fprintf(stderr, "kernel_launch: memset failed\n"); return; }
    Params p{};
    for (int i = 0; i < 18; ++i) p.in[i] = (const float*)d_in[i];
    p.out = (float*)d_out; p.ws = (unsigned char*)d_ws;
#if MK_MULTI
    for (int ph = 0; ph < N_PHASES; ++ph) {
        if (phase_is_nop(ph)) continue;
        p.ph_lo = ph; p.ph_hi = ph + 1;
        hipLaunchKernelGGL(trunk_fwd, dim3(grid), dim3(512), LDS_BYTES, stream, p);
    }
#else
    p.ph_lo = 0; p.ph_hi = N_PHASES;
    void* args[] = {&p};
    hipError_t e = hipLaunchCooperativeKernel((const void*)trunk_fwd, dim3(grid), dim3(512), args, LDS_BYTES, stream);
    if (e != hipSuccess) fprintf(stderr, "cooperative launch failed: %s (grid %d)\n", hipGetErrorString(e), grid);
#endif
}
```

```cpp
#include <hip/hip_runtime.h>
#include <hip/hip_cooperative_groups.h>
#include <cstdio>
#include <cstdint>
namespace cg = cooperative_groups;

#ifndef PH_MASK
#define PH_MASK 0xFFFF
#endif
#define PHON(k) ((PH_MASK >> (k)) & 1)
#ifndef REP_MASK
#define REP_MASK 0
#endif
#ifndef MK_MULTI
#define MK_MULTI 0
#endif

#define LAS __attribute__((address_space(3)))
typedef unsigned short bf16_t;
typedef short bf16x8 __attribute__((ext_vector_type(8)));
typedef short s16x4 __attribute__((ext_vector_type(4)));
typedef float f32x4 __attribute__((ext_vector_type(4)));
typedef float f32x16 __attribute__((ext_vector_type(16)));
typedef unsigned u32x4 __attribute__((ext_vector_type(4)));
typedef unsigned u32x2 __attribute__((ext_vector_type(2)));
typedef int i32x4 __attribute__((ext_vector_type(4)));

constexpr int NB = 4, T = 4096, M = NB * T, D = 2048, FF = 5632;
constexpr int P1_LD = 4352, P1_Q = 0, P1_K = 1024, P1_G = 2048, P1_A = 4096;
constexpr int P2_LD = 6656, P2_Q = 0, P2_C = 4096, P2_QI = 4352, P2_KI = 6400, P2_WI = 6528;
constexpr float RMS_EPS = 1e-6f;

constexpr size_t MiB = 1u << 20;
constexpr size_t WS_W = 1 * MiB;
constexpr size_t GLA_STRIDE = 33 * MiB, GLA_WINA = 0, GLA_WV = 17 * MiB, GLA_WOUT = 25 * MiB;
constexpr size_t DSA_BASE = WS_W + 66 * MiB, DSA_STRIDE = 36 * MiB, DSA_WIN = 0, DSA_WUV = 26 * MiB, DSA_WOUT = 28 * MiB;
constexpr size_t FFN_BASE = WS_W + 138 * MiB, FFN_STRIDE = 66 * MiB, FFN_W13 = 0, FFN_W2 = 44 * MiB;
constexpr size_t WS_H = 403 * MiB, WS_P = 467 * MiB, WS_VT = 603 * MiB, WS_X2 = 675 * MiB;
constexpr size_t WS_KDT = WS_X2, WS_DEC = WS_X2 + 32 * MiB, WS_O = WS_X2 + 33 * MiB;
constexpr size_t WS_CN = WS_X2, WS_KI = WS_X2 + 8 * MiB, WS_WI = WS_X2 + 12 * MiB, WS_IDX = WS_X2 + 13 * MiB, WS_OB = WS_X2 + 29 * MiB;
constexpr size_t WS_XR = 832 * MiB;
constexpr size_t WS_RSTD = 896 * MiB, WS_SS = 897 * MiB;
constexpr size_t WS_END = 900 * MiB;
constexpr int LDS_BYTES = 163840, LDS_CTL = 163584;

struct Params { const float* in[18]; float* out; unsigned char* ws; int ph_lo, ph_hi; };
struct Ctx { int tid, lane, wave, bid, G; unsigned char* ws; };

__device__ __forceinline__ float bf2f(bf16_t u) { return __builtin_bit_cast(float, (unsigned)u << 16); }
__device__ __forceinline__ float bflo(unsigned u) { return __builtin_bit_cast(float, u << 16); }
__device__ __forceinline__ float bfhi(unsigned u) { return __builtin_bit_cast(float, u & 0xffff0000u); }
typedef __bf16 bf16x2_t __attribute__((ext_vector_type(2)));
typedef float f32x2_t __attribute__((ext_vector_type(2)));
__device__ __forceinline__ unsigned pk2(float lo, float hi) { const f32x2_t v = {lo, hi}; const bf16x2_t b = __builtin_convertvector(v, bf16x2_t); return __builtin_bit_cast(unsigned, b); }
__device__ __forceinline__ float wave_sum(float v) {
#pragma unroll
    for (int o = 1; o < 64; o <<= 1) v += __shfl_xor(v, o);
    return v;
}
__device__ __forceinline__ f32x4 mfma16(bf16x8 a, bf16x8 b, f32x4 c) { return __builtin_amdgcn_mfma_f32_16x16x32_bf16(a, b, c, 0, 0, 0); }
__device__ __forceinline__ f32x16 mfma32(bf16x8 a, bf16x8 b, f32x16 c) { return __builtin_amdgcn_mfma_f32_32x32x16_bf16(a, b, c, 0, 0, 0); }

namespace pg8 {
constexpr int BM = 256, BK = 64, HALF = 128, HTB = HALF * BK * 2, STAGE_BYTES = 8 * HTB, NXCD = 8, WGM = 8;
__host__ __device__ __forceinline__ int lds_byte(int r, int c) { const int st = (r >> 4) * 2 + (c >> 5), rr = r & 15, cc = c & 31, ob = rr * 64 + cc * 2; return st * 1024 + (ob ^ (((ob >> 9) & 1) << 5)); }
__host__ __device__ __forceinline__ void stage_rc(int b, int& R, int& C) { const int st = b / 1024, sb = b % 1024, swz = sb ^ (((sb >> 9) & 1) << 5); R = (st >> 1) * 16 + swz / 64; C = (st & 1) * 32 + (swz % 64) / 2; }
__host__ __device__ __forceinline__ int perm32(int rho) { const int n = rho >> 4, i = rho & 15; return 8 * (i >> 2) + 4 * n + (i & 3); }

struct Unit { int pm, pn; };
struct Gemm { const bf16_t* A; const bf16_t* Bt; int M, N, K, lda, ldb, apn; };

struct StaticOrder {
    int nM, nN, nwg, G, c;
    __device__ void init(int M_, int N_, int G_, int c_) { nM = M_ / BM; nN = N_ / BM; nwg = nM * nN; G = G_; c = c_; }
    __device__ bool next(int i, Unit& u) const {
        const long L = (long)i * G + c; if (L >= nwg) return false;
        int wgid = (int)L; { const int q = nwg / NXCD, r = nwg % NXCD, xcd = wgid % NXCD, off = wgid / NXCD; wgid = (xcd < r ? xcd * (q + 1) : r * (q + 1) + (xcd - r) * q) + off; }
        const int nig = WGM * nN, gid = wgid / nig, fm = gid * WGM, gsz = (nM - fm) < WGM ? (nM - fm) : WGM;
        u.pm = fm + ((wgid % nig) % gsz); u.pn = (wgid % nig) / gsz; return true;
    }
};

struct EpiStore {
    bf16_t* O; int ldc; const float* rstd;
    __device__ __forceinline__ void operator()(const f32x4 (&acc)[2][2][4][2], const Unit& u, int wr, int wc, int fr, int fq) const {
        const int row0 = u.pm * BM + wr * 64 + fr, col0 = u.pn * BM + wc * 32 + 8 * fq;
        float rs[2][4];
#pragma unroll
        for (int ai = 0; ai < 2; ++ai)
#pragma unroll
            for (int m = 0; m < 4; ++m) rs[ai][m] = rstd ? rstd[row0 + ai * HALF + m * 16] : 1.0f;
#pragma unroll
        for (int ai = 0; ai < 2; ++ai)
#pragma unroll
            for (int m = 0; m < 4; ++m) { bf16_t* rowp = O + (size_t)(row0 + ai * HALF + m * 16) * ldc + col0;
#pragma unroll
                for (int bj = 0; bj < 2; ++bj) { const f32x4 v0 = acc[ai][bj][m][0] * rs[ai][m], v1 = acc[ai][bj][m][1] * rs[ai][m];
                    u32x4 w; w.x = pk2(v0[0], v0[1]); w.y = pk2(v0[2], v0[3]); w.z = pk2(v1[0], v1[1]); w.w = pk2(v1[2], v1[3]);
                    *(u32x4*)(rowp + bj * HALF) = w; } }
    }
};
struct EpiResid {
    bf16_t* xr; float* ss;
    __device__ __forceinline__ void operator()(const f32x4 (&acc)[2][2][4][2], const Unit& u, int wr, int wc, int fr, int fq) const {
        const int row0 = u.pm * BM + wr * 64 + fr, col0 = u.pn * BM + wc * 32 + 8 * fq;
#pragma unroll
        for (int ai = 0; ai < 2; ++ai)
#pragma unroll
            for (int m = 0; m < 4; ++m) { const int row = row0 + ai * HALF + m * 16; const size_t ro = (size_t)row * D + col0; float sq = 0.f;
#pragma unroll
                for (int bj = 0; bj < 2; ++bj) { const u32x4 xv = *(const u32x4*)(xr + ro + bj * HALF);
                    const f32x4 a0 = (f32x4){bflo(xv.x), bfhi(xv.x), bflo(xv.y), bfhi(xv.y)}, a1 = (f32x4){bflo(xv.z), bfhi(xv.z), bflo(xv.w), bfhi(xv.w)};
                    const f32x4 o0 = a0 + acc[ai][bj][m][0], o1 = a1 + acc[ai][bj][m][1];
                    u32x4 w; w.x = pk2(o0[0], o0[1]); w.y = pk2(o0[2], o0[3]); w.z = pk2(o1[0], o1[1]); w.w = pk2(o1[2], o1[3]);
                    *(u32x4*)(xr + ro + bj * HALF) = w;
                    sq += ((o0[0] * o0[0] + o0[1] * o0[1]) + (o0[2] * o0[2] + o0[3] * o0[3])) + ((o1[0] * o1[0] + o1[1] * o1[1]) + (o1[2] * o1[2] + o1[3] * o1[3])); }
                sq += __shfl_xor(sq, 16); sq += __shfl_xor(sq, 32);
                if (fq == 0) ss[(size_t)row * 32 + u.pn * 4 + wc] = sq; }
    }
};
struct EpiSwiglu {
    bf16_t* U; const float* rstd;
    __device__ __forceinline__ void operator()(const f32x4 (&acc)[2][2][4][2], const Unit& u, int wr, int wc, int fr, int fq) const {
        const int row0 = u.pm * BM + wr * 64 + fr, col0 = u.pn * 128 + wc * 16 + 4 * fq;
        float rs[2][4];
#pragma unroll
        for (int ai = 0; ai < 2; ++ai)
#pragma unroll
            for (int m = 0; m < 4; ++m) rs[ai][m] = rstd[row0 + ai * HALF + m * 16];
#pragma unroll
        for (int ai = 0; ai < 2; ++ai)
#pragma unroll
            for (int m = 0; m < 4; ++m) { bf16_t* rowp = U + (size_t)(row0 + ai * HALF + m * 16) * FF + col0;
#pragma unroll
                for (int bj = 0; bj < 2; ++bj) { const f32x4 g = acc[ai][bj][m][0] * rs[ai][m], v = acc[ai][bj][m][1] * rs[ai][m]; float o[4];
#pragma unroll
                    for (int i = 0; i < 4; ++i) { const float e = __builtin_amdgcn_exp2f(-1.44269504089f * g[i]); o[i] = g[i] * __builtin_amdgcn_rcpf(1.0f + e) * v[i]; }
                    u32x2 w; w.x = pk2(o[0], o[1]); w.y = pk2(o[2], o[3]);
                    *(u32x2*)(rowp + bj * 64) = w; } }
    }
};

template <class Epi, class Sched>
__device__ __forceinline__ void gemm_phase(LAS unsigned char* lds, const Gemm g, const Sched& S, const Epi& E, const int tid) {
    const int wid = __builtin_amdgcn_readfirstlane(tid >> 6), lane = tid & 63, wr = wid >> 2, wc = wid & 3, fr = lane & 15, fq = lane >> 4;
    const int K = g.K, nt = K / BK;
    unsigned voffA[2], voffB[2];
#pragma unroll
    for (int i = 0; i < 2; ++i) { int R, C; stage_rc(tid * 16 + i * 8192, R, C); const int Rb = (R & ~31) + perm32(R & 31);
        voffA[i] = (unsigned)(R * g.lda + C) * 2u; voffB[i] = (unsigned)(Rb * g.ldb + C) * 2u; }
    const size_t kstep = (size_t)(BK * 2);
    const size_t hstepA = (size_t)HALF * g.lda * 2, hstepB = (size_t)HALF * g.ldb * 2;
    const size_t tstepA = 2 * hstepA, tstepB = 2 * hstepB, pnA = (size_t)g.apn * 2;
    const unsigned ldsw = (unsigned)wid * 1024u;
    const int aoff = lds_byte(wr * 64 + fr, fq * 8), boff = lds_byte(wc * 32 + fr, fq * 8);
#define PG8_SA(b, h) (((b) * 2 + (h)) * HTB)
#define PG8_SB(b, h) ((4 + (b) * 2 + (h)) * HTB)
#define PG8_STAGE(bufoff, gbase, voff) do { _Pragma("unroll") for (int _i = 0; _i < 2; ++_i) \
        __builtin_amdgcn_global_load_lds((const unsigned*)((const char*)(gbase) + (voff)[_i]), (LAS unsigned*)(lds + (bufoff) + ldsw + _i * 8192), 16, 0, 0); } while (0)
#define PG8_LDA(dst, b, h) do { _Pragma("unroll") for (int m = 0; m < 4; ++m) _Pragma("unroll") for (int k = 0; k < 2; ++k) dst[m][k] = *(const LAS bf16x8*)(lds + PG8_SA(b, h) + aoff + m * 2048 + k * 1024); } while (0)
#define PG8_LDB(dst, b, h) do { _Pragma("unroll") for (int n = 0; n < 2; ++n) _Pragma("unroll") for (int k = 0; k < 2; ++k) dst[n][k] = *(const LAS bf16x8*)(lds + PG8_SB(b, h) + boff + n * 2048 + k * 1024); } while (0)
#define PG8_MMA(ai, bj, At, Bt) do { __builtin_amdgcn_s_setprio(1); _Pragma("unroll") for (int m = 0; m < 4; ++m) _Pragma("unroll") for (int n = 0; n < 2; ++n) _Pragma("unroll") for (int k = 0; k < 2; ++k) \
        acc[ai][bj][m][n] = __builtin_amdgcn_mfma_f32_16x16x32_bf16(Bt[n][k], At[m][k], acc[ai][bj][m][n], 0, 0, 0); __builtin_amdgcn_s_setprio(0); } while (0)
#define PG8_WAIT_V(n) asm volatile("s_waitcnt vmcnt(" #n ")" ::: "memory")
#define PG8_WAIT_L(n) asm volatile("s_waitcnt lgkmcnt(" #n ")" ::: "memory")
#define PG8_BAR __builtin_amdgcn_s_barrier()
#define PG8_SCHED __builtin_amdgcn_sched_barrier(0)
    Unit cur, nxt; int ui = 0;
    if (!S.next(0, cur)) return;
    f32x4 acc[2][2][4][2];
#pragma unroll
    for (int a = 0; a < 2; ++a)
#pragma unroll
        for (int b = 0; b < 2; ++b)
#pragma unroll
            for (int m = 0; m < 4; ++m)
#pragma unroll
                for (int n = 0; n < 2; ++n) acc[a][b][m][n] = (f32x4){0.f, 0.f, 0.f, 0.f};
    bf16x8 At[4][2], B0[2][2], B1[2][2];
    const char* cA = (const char*)g.A + (size_t)cur.pm * tstepA + (size_t)cur.pn * pnA; const char* cB = (const char*)g.Bt + (size_t)cur.pn * tstepB;
    PG8_STAGE(PG8_SB(0, 0), cB, voffB); PG8_STAGE(PG8_SB(0, 1), cB + hstepB, voffB); PG8_STAGE(PG8_SA(0, 0), cA, voffA); PG8_STAGE(PG8_SA(0, 1), cA + hstepA, voffA);
    if (wr == 1) PG8_BAR;
    PG8_WAIT_V(2); PG8_BAR;
    PG8_STAGE(PG8_SB(1, 0), cB + kstep, voffB); PG8_STAGE(PG8_SA(1, 0), cA + kstep, voffA); PG8_STAGE(PG8_SB(1, 1), cB + hstepB + kstep, voffB);
    PG8_WAIT_V(6); PG8_BAR;
    for (;;) {
        const bool has_next = S.next(ui + 1, nxt);
        const char* nA = has_next ? (const char*)g.A + (size_t)nxt.pm * tstepA + (size_t)nxt.pn * pnA : cA; const char* nB = has_next ? (const char*)g.Bt + (size_t)nxt.pn * tstepB : cB;
        for (int t = 0; t < nt; t += 2) {
            const bool last = (t == nt - 2);
            const char* a1 = cA + (size_t)(t + 1) * kstep;
            const char* a2 = last ? nA : cA + (size_t)(t + 2) * kstep; const char* b2 = last ? nB : cB + (size_t)(t + 2) * kstep;
            const char* a3 = a2 + kstep; const char* b3 = b2 + kstep;
            PG8_LDB(B0, 0, 0); PG8_LDB(B1, 0, 1); PG8_SCHED; PG8_LDA(At, 0, 0); PG8_STAGE(PG8_SA(1, 1), a1 + hstepA, voffA);
            PG8_WAIT_V(8); PG8_WAIT_L(0); PG8_BAR; PG8_MMA(0, 0, At, B0); PG8_MMA(0, 1, At, B1); PG8_BAR; PG8_SCHED;
            PG8_LDA(At, 0, 1); PG8_STAGE(PG8_SB(0, 0), b2, voffB); PG8_STAGE(PG8_SB(0, 1), b2 + hstepB, voffB); PG8_STAGE(PG8_SA(0, 0), a2, voffA);
            PG8_WAIT_V(8); PG8_WAIT_L(0); PG8_BAR; PG8_MMA(1, 0, At, B0); PG8_MMA(1, 1, At, B1); PG8_BAR; PG8_SCHED;
            PG8_LDB(B0, 1, 0); PG8_LDB(B1, 1, 1); PG8_SCHED; PG8_LDA(At, 1, 0); PG8_STAGE(PG8_SA(0, 1), a2 + hstepA, voffA);
            PG8_WAIT_V(8); PG8_WAIT_L(0); PG8_BAR; PG8_MMA(0, 0, At, B0); PG8_MMA(0, 1, At, B1); PG8_BAR; PG8_SCHED;
            PG8_LDA(At, 1, 1); PG8_STAGE(PG8_SB(1, 0), b3, voffB); PG8_STAGE(PG8_SB(1, 1), b3 + hstepB, voffB); PG8_STAGE(PG8_SA(1, 0), a3, voffA);
            PG8_WAIT_V(8); PG8_WAIT_L(0); PG8_BAR; PG8_MMA(1, 0, At, B0); PG8_MMA(1, 1, At, B1); PG8_BAR; PG8_SCHED;
        }
        if (wr == 0) PG8_BAR;
        E(acc, cur, wr, wc, fr, fq);
        if (!has_next) break;
#pragma unroll
        for (int a = 0; a < 2; ++a)
#pragma unroll
            for (int b = 0; b < 2; ++b)
#pragma unroll
                for (int m = 0; m < 4; ++m)
#pragma unroll
                    for (int n = 0; n < 2; ++n) acc[a][b][m][n] = (f32x4){0.f, 0.f, 0.f, 0.f};
        cur = nxt; cA = nA; cB = nB; ++ui;
        if (wr == 1) PG8_BAR;
    }
    PG8_WAIT_V(0);
    PG8_BAR;
#undef PG8_SA
#undef PG8_SB
#undef PG8_STAGE
#undef PG8_LDA
#undef PG8_LDB
#undef PG8_MMA
#undef PG8_WAIT_V
#undef PG8_WAIT_L
#undef PG8_BAR
#undef PG8_SCHED
}
}

struct TrSeg { const float* W; int ldw, ncols, K; bf16_t* WT; int ldt, row_off, mode; const float* gain; };
__device__ __forceinline__ void tr_item(const TrSeg& s, int kb, int nb, LAS float* scr, int lane) {
    const int k0 = 64 * kb, n0 = 64 * nb;
    const int c4 = (lane & 15) * 4, kq = lane >> 4;
    const bool okc = (n0 + c4) < s.ncols;
    const float* src = s.W + (size_t)(k0 + kq) * s.ldw + n0 + c4;
    f32x4 v[16];
#pragma unroll
    for (int i = 0; i < 16; ++i) v[i] = okc ? __builtin_nontemporal_load((const f32x4*)(src + (size_t)(4 * i) * s.ldw)) : (f32x4){0.f, 0.f, 0.f, 0.f};
    if (s.gain) {
#pragma unroll
        for (int i = 0; i < 16; ++i) v[i] = v[i] * s.gain[k0 + 4 * i + kq]; }
#pragma unroll
    for (int i = 0; i < 16; ++i) { LAS float* d = scr + (4 * i + kq) * 65 + c4; d[0] = v[i][0]; d[1] = v[i][1]; d[2] = v[i][2]; d[3] = v[i][3]; }
    asm volatile("s_waitcnt lgkmcnt(0)" ::: "memory");
    const int c = lane & 7;
#pragma unroll
    for (int j = 0; j < 8; ++j) { const int n = (lane >> 3) + 8 * j, gn = n0 + n; const LAS float* sp = scr + (8 * c) * 65 + n;
        u32x4 o; o.x = pk2(sp[0 * 65], sp[1 * 65]); o.y = pk2(sp[2 * 65], sp[3 * 65]); o.z = pk2(sp[4 * 65], sp[5 * 65]); o.w = pk2(sp[6 * 65], sp[7 * 65]);
        const int row = s.mode ? (8 * (gn >> 2) + (gn & 3) + s.row_off) : (s.row_off + gn);
        if (gn < s.ncols) *(u32x4*)(s.WT + (size_t)row * s.ldt + k0 + 8 * c) = o; }
    asm volatile("s_waitcnt lgkmcnt(0)" ::: "memory");
}
__device__ __forceinline__ void tr_run(const TrSeg& s, int& next, int& base, int NGW, LAS float* scr, int lane) {
    const int nnb = (s.ncols + 63) >> 6, n = (s.K >> 6) * nnb;
    while (next < base + n) { const int it = next - base; tr_item(s, it / nnb, it % nnb, scr, lane); next += NGW; }
    base += n;
}
__device__ __forceinline__ void prologue_phase(const Params& p, const Ctx& cx, LAS unsigned char* lds) {
    const int wave = cx.wave, lane = cx.lane, G = cx.G, gw = cx.bid * 8 + wave, NGW = G * 8;
    LAS float* scr = (LAS float*)(lds + wave * 16640);
    unsigned char* ws = cx.ws;
    int next = gw, base = 0;
    for (int i = 3; i >= 0; --i) {
        bf16_t* W13 = (bf16_t*)(ws + FFN_BASE + i * FFN_STRIDE + FFN_W13); bf16_t* W2 = (bf16_t*)(ws + FFN_BASE + i * FFN_STRIDE + FFN_W2);
        { TrSeg s{p.in[15] + (size_t)i * D * FF, FF, FF, D, W13, D, 0, 1, p.in[2] + (size_t)i * D}; tr_run(s, next, base, NGW, scr, lane); }
        { TrSeg s{p.in[16] + (size_t)i * D * FF, FF, FF, D, W13, D, 4, 1, p.in[2] + (size_t)i * D}; tr_run(s, next, base, NGW, scr, lane); }
        { TrSeg s{p.in[17] + (size_t)i * FF * D, D, D, FF, W2, FF, 0, 0, nullptr}; tr_run(s, next, base, NGW, scr, lane); }
    }
    for (int j = 1; j >= 0; --j) {
        bf16_t* Win = (bf16_t*)(ws + DSA_BASE + j * DSA_STRIDE + DSA_WIN); bf16_t* Wuv = (bf16_t*)(ws + DSA_BASE + j * DSA_STRIDE + DSA_WUV); bf16_t* Wo = (bf16_t*)(ws + DSA_BASE + j * DSA_STRIDE + DSA_WOUT);
        { TrSeg s{p.in[9] + (size_t)j * D * 6544, 6544, 6544, D, Win, D, 0, 0, p.in[1] + (size_t)(2 * j + 1) * D}; tr_run(s, next, base, NGW, scr, lane); }
        for (int h = 0; h < 16; ++h) {
            TrSeg s{p.in[12] + (size_t)(j * 16 + h) * 256 * 128, 128, 128, 256, Wuv + (size_t)((h >> 1) * 256 + (h & 1) * 128) * 512 + (h & 1) * 256, 512, 0, 0, nullptr};
            tr_run(s, next, base, NGW, scr, lane);
        }
        { TrSeg s{p.in[13] + (size_t)j * D * D, D, D, D, Wo, D, 0, 0, nullptr}; tr_run(s, next, base, NGW, scr, lane); }
        for (int i = cx.bid * 512 + cx.tid; i < 65536; i += G * 512) {
            const int blk = i >> 12, r = (i >> 5) & 127, ch = i & 31, pn = blk >> 1, hh = blk & 1;
            *(u32x4*)(Wuv + (size_t)(pn * 256 + hh * 128 + r) * 512 + (1 - hh) * 256 + ch * 8) = (u32x4){0u, 0u, 0u, 0u};
        }
    }
    for (int j = 1; j >= 0; --j) {
        const float* w_in = p.in[4] + (size_t)j * D * 6160;
        const float* gmix = p.in[1] + (size_t)(2 * j) * D;
        bf16_t* WinA = (bf16_t*)(ws + WS_W + j * GLA_STRIDE + GLA_WINA); bf16_t* Wv = (bf16_t*)(ws + WS_W + j * GLA_STRIDE + GLA_WV); bf16_t* Wo = (bf16_t*)(ws + WS_W + j * GLA_STRIDE + GLA_WOUT);
        { TrSeg s{w_in, 6160, 2048, D, WinA, D, 0, 0, gmix}; tr_run(s, next, base, NGW, scr, lane); }
        { TrSeg s{w_in + 2048, 6160, 2048, D, Wv, D, 0, 0, gmix}; tr_run(s, next, base, NGW, scr, lane); }
        { TrSeg s{w_in + 4096, 6160, 2048, D, WinA, D, 2048, 0, gmix}; tr_run(s, next, base, NGW, scr, lane); }
        { TrSeg s{w_in + 6144, 6160, 16, D, WinA, D, 4096, 0, gmix}; tr_run(s, next, base, NGW, scr, lane); }
        { TrSeg s{p.in[8] + (size_t)j * D * D, D, D, D, Wo, D, 0, 0, nullptr}; tr_run(s, next, base, NGW, scr, lane); }
    }
    bf16_t* XR = (bf16_t*)(ws + WS_XR); float* RS = (float*)(ws + WS_RSTD);
    for (int m = gw; m < M; m += NGW) {
        const f32x4* xr = (const f32x4*)(p.in[0] + (size_t)m * D) + lane; u32x2* o = (u32x2*)(XR + (size_t)m * D) + lane; float sq = 0.f;
#pragma unroll
        for (int jq = 0; jq < 8; ++jq) { const f32x4 v = __builtin_nontemporal_load(xr + 64 * jq); sq += (v[0] * v[0] + v[1] * v[1]) + (v[2] * v[2] + v[3] * v[3]); u32x2 w; w.x = pk2(v[0], v[1]); w.y = pk2(v[2], v[3]); o[64 * jq] = w; }
        sq = wave_sum(sq);
        if (lane == 0) RS[m] = 1.0f / sqrtf(sq * (1.0f / D) + RMS_EPS);
    }
}

template <bool BF16IN, bool F32OUT>
__device__ __forceinline__ void rms_phase(const void* xp, const float* g, void* outp, const Ctx& cx) {
    const int lane = cx.lane, gw = cx.bid * 8 + cx.wave, NGW = cx.G * 8;
    f32x4 gv[8], nx[8];
#pragma unroll
    for (int j = 0; j < 8; ++j) gv[j] = ((const f32x4*)g)[lane + 64 * j];
#define RMS_LOAD(ROW) do { if (BF16IN) { const u32x2* xr_ = (const u32x2*)((const bf16_t*)xp + (size_t)(ROW) * D) + lane; \
            _Pragma("unroll") for (int j = 0; j < 8; ++j) { const u32x2 t_ = xr_[64 * j]; nx[j] = (f32x4){bflo(t_.x), bfhi(t_.x), bflo(t_.y), bfhi(t_.y)}; } } \
        else { const f32x4* xr_ = (const f32x4*)((const float*)xp + (size_t)(ROW) * D) + lane; _Pragma("unroll") for (int j = 0; j < 8; ++j) nx[j] = xr_[64 * j]; } } while (0)
    if (gw < M) RMS_LOAD(gw);
    for (int m = gw; m < M; m += NGW) {
        f32x4 v[8]; float s = 0.f;
#pragma unroll
        for (int j = 0; j < 8; ++j) v[j] = nx[j];
        if (m + NGW < M) RMS_LOAD(m + NGW);
#pragma unroll
        for (int j = 0; j < 8; ++j) s += (v[j][0] * v[j][0] + v[j][1] * v[j][1]) + (v[j][2] * v[j][2] + v[j][3] * v[j][3]);
        s = wave_sum(s);
        const float r = 1.0f / sqrtf(s * (1.0f / D) + RMS_EPS);
        if (F32OUT) { f32x4* o = (f32x4*)((float*)outp + (size_t)m * D) + lane;
#pragma unroll
            for (int j = 0; j < 8; ++j) o[64 * j] = v[j] * r * gv[j];
        } else { u32x2* o = (u32x2*)((bf16_t*)outp + (size_t)m * D) + lane;
#pragma unroll
            for (int j = 0; j < 8; ++j) { const f32x4 y = v[j] * r * gv[j]; u32x2 w; w.x = pk2(y[0], y[1]); w.y = pk2(y[2], y[3]); o[64 * j] = w; } }
    }
#undef RMS_LOAD
}
__device__ __forceinline__ void rstd_phase(const Ctx& cx) {
    const float* SS = (const float*)(cx.ws + WS_SS); float* RS = (float*)(cx.ws + WS_RSTD);
    for (int m = cx.bid * 512 + cx.tid; m < M; m += cx.G * 512) {
        const f32x4* sp = (const f32x4*)(SS + (size_t)m * 32); float t = 0.f;
#pragma unroll
        for (int q = 0; q < 8; ++q) { const f32x4 a = sp[q]; t += (a[0] + a[1]) + (a[2] + a[3]); }
        RS[m] = 1.0f / sqrtf(t * (1.0f / D) + RMS_EPS);
    }
}
__device__ __forceinline__ float fexp(float x) { return __builtin_amdgcn_exp2f(x * 1.44269504089f); }
__device__ __forceinline__ float log_sigmoid(float z) { return fminf(z, 0.f) - __builtin_amdgcn_logf(1.0f + fexp(-fabsf(z))) * 0.69314718056f; }
__device__ __forceinline__ void gla_gate_phase(const Params& p, const Ctx& cx, int j, LAS unsigned char* lds) {
    const bf16_t* P1 = (const bf16_t*)(cx.ws + WS_P); bf16_t* KDT = (bf16_t*)(cx.ws + WS_KDT); float* DEC = (float*)(cx.ws + WS_DEC);
    const bf16_t* H = (const bf16_t*)(cx.ws + WS_XR); const float* RS = (const float*)(cx.ws + WS_RSTD); const bf16_t* Wa = (const bf16_t*)(cx.ws + WS_W + (size_t)j * GLA_STRIDE + GLA_WINA) + (size_t)4096 * D;
    const float* w_a2 = p.in[5] + (size_t)j * 16 * 1024; const float* b_a = p.in[6] + (size_t)j * 1024;
    const int wave = cx.wave, lane = cx.lane, fr = lane & 15, fq = lane >> 4;
    LAS float* al = (LAS float*)(lds + 32768);
    for (int it = cx.bid; it < 512; it += cx.G) {
        const int bc = it >> 1, kcol = (it & 1) * 512 + cx.tid, b = bc >> 6, c = bc & 63, tok0 = b * T + c * 64;
        __syncthreads();
        {
            f32x4 acc[4];
#pragma unroll
            for (int tt = 0; tt < 4; ++tt) acc[tt] = (f32x4){0.f, 0.f, 0.f, 0.f};
            const bf16_t* hp = H + (size_t)(tok0 + fr) * D + 256 * wave + 8 * fq;
            const bf16_t* wp = Wa + (size_t)fr * D + 256 * wave + 8 * fq;
#pragma unroll
            for (int ss = 0; ss < 8; ++ss) { const bf16x8 bfg = *(const bf16x8*)(wp + 32 * ss);
#pragma unroll
                for (int tt = 0; tt < 4; ++tt) { const bf16x8 afg = *(const bf16x8*)(hp + (size_t)(16 * tt) * D + 32 * ss); acc[tt] = mfma16(afg, bfg, acc[tt]); } }
#pragma unroll
            for (int tt = 0; tt < 4; ++tt) *(LAS f32x4*)(lds + ((wave * 4 + tt) * 64 + lane) * 16) = acc[tt];
        }
        __syncthreads();
        if (cx.tid < 256) { const int tt = cx.tid >> 6, l2 = cx.tid & 63;
            f32x4 v = *(const LAS f32x4*)(lds + (tt * 64 + l2) * 16);
#pragma unroll
            for (int w8 = 1; w8 < 8; ++w8) v = v + *(const LAS f32x4*)(lds + ((w8 * 4 + tt) * 64 + l2) * 16);
            const int tokl = 16 * tt + 4 * (l2 >> 4), r = l2 & 15;
            const f32x4 rq = *(const f32x4*)(RS + tok0 + tokl);
#pragma unroll
            for (int i = 0; i < 4; ++i) al[(tokl + i) * 16 + r] = v[i] * rq[i]; }
        __syncthreads();
        float w[16];
#pragma unroll
        for (int r = 0; r < 16; ++r) w[r] = w_a2[r * 1024 + kcol];
        const float bias = b_a[kcol];
        float cum = 0.f;
        for (int t = 0; t < 64; ++t) {
            const LAS f32x4* ap = (const LAS f32x4*)(al + t * 16); const f32x4 a0 = ap[0], a1 = ap[1], a2 = ap[2], a3 = ap[3];
            float z = bias;
#pragma unroll
            for (int r = 0; r < 4; ++r) { z += a0[r] * w[r] + a1[r] * w[4 + r]; z += a2[r] * w[8 + r] + a3[r] * w[12 + r]; }
            cum += log_sigmoid(z) * (1.0f / 16.0f);
        }
        const float ltot = cum; cum = 0.f;
        for (int t8 = 0; t8 < 8; ++t8) {
            float kd[8];
#pragma unroll
            for (int e = 0; e < 8; ++e) {
                const int t = 8 * t8 + e;
                const LAS f32x4* ap = (const LAS f32x4*)(al + t * 16); const f32x4 a0 = ap[0], a1 = ap[1], a2 = ap[2], a3 = ap[3];
                float z = bias;
#pragma unroll
                for (int r = 0; r < 4; ++r) { z += a0[r] * w[r] + a1[r] * w[4 + r]; z += a2[r] * w[8 + r] + a3[r] * w[12 + r]; }
                cum += log_sigmoid(z) * (1.0f / 16.0f);
                kd[e] = bf2f(P1[(size_t)(tok0 + t) * P1_LD + P1_K + kcol]) * fexp(ltot - cum) * RS[tok0 + t];
            }
            u32x4 o; o.x = pk2(kd[0], kd[1]); o.y = pk2(kd[2], kd[3]); o.z = pk2(kd[4], kd[5]); o.w = pk2(kd[6], kd[7]);
            *(u32x4*)(KDT + (size_t)kcol * M + tok0 + 8 * t8) = o;
        }
        DEC[(size_t)bc * 1024 + kcol] = fexp(ltot);
    }
}

constexpr int SC_KDB = 144, SC_QB = 528, SC_KD_BYTES = 256 * SC_KDB, SC_DEC_OFF = SC_KD_BYTES + 64 * SC_QB, SC_BUF = SC_DEC_OFF + 1024, SC_PART = SC_BUF;
__device__ __forceinline__ void gla_scan_phase(const Params& p, const Ctx& cx, LAS unsigned char* lds) {
    const bf16_t* P1 = (const bf16_t*)(cx.ws + WS_P); const bf16_t* VT = (const bf16_t*)(cx.ws + WS_VT); const bf16_t* KDT = (const bf16_t*)(cx.ws + WS_KDT);
    const float* DEC = (const float*)(cx.ws + WS_DEC); bf16_t* O = (bf16_t*)(cx.ws + WS_O);
    const int tid = cx.tid, wave = cx.wave, lane = cx.lane, G = cx.G, fr = lane & 15, fq = lane >> 4;
    const int vt = wave & 1, kq = wave >> 1;
    for (int item = cx.bid; item < 256; item += G) {
        int bh, vg; if (G == 256) { const int r_ = item >> 3; bh = (item & 7) + 8 * (r_ >> 4); vg = r_ & 15; } else { bh = item >> 4; vg = item & 15; }
        const int b = bh >> 2, h = bh & 3, v0 = vg * 32 + vt * 16;
        const bf16_t* gk = KDT + (size_t)(h * 256 + (tid >> 3)) * M + b * T + (tid & 7) * 8;
        const bf16_t* gq = P1 + (size_t)(b * T + (tid >> 5)) * P1_LD + P1_Q + h * 256 + (tid & 31) * 8;
        const float* gd = DEC + (size_t)(b * 64) * 1024 + h * 256 + (tid & 63) * 4;
        const int lk = (tid >> 3) * SC_KDB + (tid & 7) * 16, lq = SC_KD_BYTES + (tid >> 5) * SC_QB + (tid & 31) * 16;
        u32x4 pk[4], pq[4]; f32x4 pd = (f32x4){0.f, 0.f, 0.f, 0.f};
        __syncthreads();
#pragma unroll
        for (int i = 0; i < 4; ++i) { pk[i] = *(const u32x4*)(gk + (size_t)i * 64 * M); pq[i] = *(const u32x4*)(gq + (size_t)i * 16 * P1_LD); }
        if (tid < 64) pd = *(const f32x4*)gd;
#pragma unroll
        for (int i = 0; i < 4; ++i) { *(LAS u32x4*)(lds + lk + i * 64 * SC_KDB) = pk[i]; *(LAS u32x4*)(lds + lq + i * 16 * SC_QB) = pq[i]; }
        if (tid < 64) *(LAS f32x4*)(lds + SC_DEC_OFF + tid * 16) = pd;
        __syncthreads();
        f32x4 S[4];
#pragma unroll
        for (int i = 0; i < 4; ++i) S[i] = (f32x4){0.f, 0.f, 0.f, 0.f};
        const bf16_t* vtrow = VT + (size_t)(h * 512 + v0 + fr) * M + b * T + 8 * fq;
        bf16x8 nv0 = *(const bf16x8*)vtrow, nv1 = *(const bf16x8*)(vtrow + 32);
        const LAS unsigned char* kdb = lds + (64 * kq + fr) * SC_KDB + 16 * fq;
        const LAS unsigned char* decl = lds + SC_DEC_OFF + 256 * kq + 16 * fq;
        const LAS unsigned char* qb = lds + SC_KD_BYTES + fr * SC_QB + 128 * kq + 8 * fq;
        LAS unsigned char* pw = lds + SC_PART + wave * 4096 + lane * 16;
        const LAS unsigned char* pr = lds + SC_PART + vt * 4096 + kq * 1024 + lane * 16;
        for (int c = 0; c < 64; ++c) {
            const int tokc = c * 64;
            const bf16x8 vf0 = nv0, vf1 = nv1;
            if (c + 1 < 64) {
#pragma unroll
                for (int i = 0; i < 4; ++i) { pk[i] = *(const u32x4*)(gk + (size_t)i * 64 * M + tokc + 64); pq[i] = *(const u32x4*)(gq + (size_t)i * 16 * P1_LD + (size_t)(tokc + 64) * P1_LD); }
                nv0 = *(const bf16x8*)(vtrow + tokc + 64); nv1 = *(const bf16x8*)(vtrow + tokc + 96); if (tid < 64) pd = *(const f32x4*)(gd + (size_t)(c + 1) * 1024);
            }
#pragma unroll
            for (int j = 0; j < 4; ++j) {
                const f32x4 d = *(const LAS f32x4*)(decl + 64 * j);
                const bf16x8 a0 = *(const LAS bf16x8*)(kdb + j * 16 * SC_KDB), a1 = *(const LAS bf16x8*)(kdb + j * 16 * SC_KDB + 64);
                f32x4 sv = S[j] * d;
                sv = mfma16(a0, vf0, sv); sv = mfma16(a1, vf1, sv); S[j] = sv;
            }
            bf16x8 sf[2];
#pragma unroll
            for (int ks = 0; ks < 2; ++ks) { u32x4 w; w.x = pk2(S[2 * ks][0], S[2 * ks][1]); w.y = pk2(S[2 * ks][2], S[2 * ks][3]); w.z = pk2(S[2 * ks + 1][0], S[2 * ks + 1][1]); w.w = pk2(S[2 * ks + 1][2], S[2 * ks + 1][3]);
                sf[ks] = __builtin_bit_cast(bf16x8, w); }
#pragma unroll
            for (int ct = 0; ct < 4; ++ct) {
                f32x4 o = (f32x4){0.f, 0.f, 0.f, 0.f};
#pragma unroll
                for (int ks = 0; ks < 2; ++ks) {
                    const u32x2 q0 = *(const LAS u32x2*)(qb + ct * 16 * SC_QB + 64 * ks), q1 = *(const LAS u32x2*)(qb + ct * 16 * SC_QB + 64 * ks + 32);
                    u32x4 qw; qw.x = q0.x; qw.y = q0.y; qw.z = q1.x; qw.w = q1.y;
                    o = mfma16(sf[ks], __builtin_bit_cast(bf16x8, qw), o);
                }
                *(LAS f32x4*)(pw + ct * 1024) = o;
            }
            __syncthreads();
            {
                f32x4 o = *(const LAS f32x4*)pr;
#pragma unroll
                for (int k2 = 1; k2 < 4; ++k2) o = o + *(const LAS f32x4*)(pr + k2 * 8192);
                u32x2 w; w.x = pk2(o[0] * 0.0625f, o[1] * 0.0625f); w.y = pk2(o[2] * 0.0625f, o[3] * 0.0625f);
                *(u32x2*)(O + (size_t)(b * T + tokc + 16 * kq + fr) * D + h * 512 + v0 + 4 * fq) = w;
            }
            if (c + 1 < 64) {
#pragma unroll
                for (int i = 0; i < 4; ++i) { *(LAS u32x4*)(lds + lk + i * 64 * SC_KDB) = pk[i]; *(LAS u32x4*)(lds + lq + i * 16 * SC_QB) = pq[i]; }
                if (tid < 64) *(LAS f32x4*)(lds + SC_DEC_OFF + tid * 16) = pd;
            }
            __syncthreads();
        }
    }
}

__device__ __forceinline__ void gla_normgate_phase(const Params& p, const Ctx& cx, int j) {
    const int wave = cx.wave, lane = cx.lane;
    const bf16_t* P1 = (const bf16_t*)(cx.ws + WS_P); const bf16_t* O = (const bf16_t*)(cx.ws + WS_O); bf16_t* A2 = (bf16_t*)(cx.ws + WS_H);
    const float* gn = p.in[7] + (size_t)j * 512 + lane * 8;
    const f32x4 g0 = *(const f32x4*)gn, g1 = *(const f32x4*)(gn + 4);
    const int gw = cx.bid * 8 + wave, NGW = cx.G * 8;
    u32x4 no[4], ng[4];
    if (gw < M) {
#pragma unroll
        for (int h = 0; h < 4; ++h) { no[h] = *(const u32x4*)(O + (size_t)gw * D + h * 512 + lane * 8); ng[h] = *(const u32x4*)(P1 + (size_t)gw * P1_LD + P1_G + h * 512 + lane * 8); }
    }
    for (int tok = gw; tok < M; tok += NGW) {
        u32x4 ovv[4], gvv[4];
#pragma unroll
        for (int h = 0; h < 4; ++h) { ovv[h] = no[h]; gvv[h] = ng[h]; }
        if (tok + NGW < M) {
#pragma unroll
            for (int h = 0; h < 4; ++h) { no[h] = *(const u32x4*)(O + (size_t)(tok + NGW) * D + h * 512 + lane * 8); ng[h] = *(const u32x4*)(P1 + (size_t)(tok + NGW) * P1_LD + P1_G + h * 512 + lane * 8); }
        }
#pragma unroll
        for (int h = 0; h < 4; ++h) {
            const u32x4 ov = ovv[h], gv = gvv[h];
            float v[8], g[8];
#pragma unroll
            for (int i = 0; i < 4; ++i) { v[2 * i] = bflo(ov[i]); v[2 * i + 1] = bfhi(ov[i]); g[2 * i] = bflo(gv[i]); g[2 * i + 1] = bfhi(gv[i]); }
            float ss = 0.f;
#pragma unroll
            for (int i = 0; i < 8; ++i) ss += v[i] * v[i];
            ss = wave_sum(ss);
            const float r = __builtin_amdgcn_rsqf(ss * (1.0f / 512.0f) + RMS_EPS);
            float y[8];
#pragma unroll
            for (int i = 0; i < 8; ++i) { const float gg = (i < 4) ? g0[i] : g1[i - 4]; y[i] = v[i] * r * gg * (g[i] * __builtin_amdgcn_rcpf(1.0f + fexp(-g[i]))); }
            u32x4 w; w.x = pk2(y[0], y[1]); w.y = pk2(y[2], y[3]); w.z = pk2(y[4], y[5]); w.w = pk2(y[6], y[7]);
            *(u32x4*)(A2 + (size_t)tok * D + h * 512 + lane * 8) = w;
        }
    }
}

__device__ __forceinline__ void dsa_post_phase(const Params& p, const Ctx& cx, int j) {
    const int wave = cx.wave, lane = cx.lane;
    const bf16_t* P2 = (const bf16_t*)(cx.ws + WS_P); bf16_t* CN = (bf16_t*)(cx.ws + WS_CN); bf16_t* KI = (bf16_t*)(cx.ws + WS_KI); float* WI = (float*)(cx.ws + WS_WI);
    const f32x4 kvn = *(const f32x4*)(p.in[10] + (size_t)j * 256 + lane * 4);
    const float kn0 = p.in[11][(size_t)j * 128 + lane * 2], kn1 = p.in[11][(size_t)j * 128 + lane * 2 + 1];
    const int gw = cx.bid * 8 + wave, NGW = cx.G * 8;
    for (int m = gw; m < M; m += NGW) {
        const bf16_t* row = P2 + (size_t)m * P2_LD;
        const u32x2 cv = *(const u32x2*)(row + P2_C + lane * 4);
        const float c0 = bflo(cv.x), c1 = bfhi(cv.x), c2 = bflo(cv.y), c3 = bfhi(cv.y);
        float ss = wave_sum((c0 * c0 + c1 * c1) + (c2 * c2 + c3 * c3));
        float r = 1.0f / sqrtf(ss * (1.0f / 256.0f) + RMS_EPS);
        u32x2 w; w.x = pk2(c0 * r * kvn[0], c1 * r * kvn[1]); w.y = pk2(c2 * r * kvn[2], c3 * r * kvn[3]);
        *(u32x2*)(CN + (size_t)m * 256 + lane * 4) = w;
        const unsigned kv = *(const unsigned*)(row + P2_KI + lane * 2);
        const float k0 = bflo(kv), k1 = bfhi(kv);
        ss = wave_sum(k0 * k0 + k1 * k1);
        r = 1.0f / sqrtf(ss * (1.0f / 128.0f) + RMS_EPS);
        *(unsigned*)(KI + (size_t)m * 128 + lane * 2) = pk2(k0 * r * kn0, k1 * r * kn1);
        if (lane < 16) WI[(size_t)m * 16 + lane] = bf2f(row[P2_WI + lane]) * (0.25f * 0.08838834764831845f);
    }
}

__device__ __forceinline__ void dsa_index_phase(const Params& p, const Ctx& cx, LAS unsigned char* lds) {
    const int wave = cx.wave, lane = cx.lane;
    const bf16_t* P2 = (const bf16_t*)(cx.ws + WS_P); const bf16_t* KI = (const bf16_t*)(cx.ws + WS_KI); const float* WI = (const float*)(cx.ws + WS_WI); int* IDX = (int*)(cx.ws + WS_IDX);
    const int G = cx.G;
    const int pair = wave >> 1, kh = wave & 1, rho = lane & 31, hA = lane >> 5;
    for (int k = 0;; ++k) {
        const int it = cx.bid + k * G; if (it >= 2048) break;
        int b, pos; if (G == 256) { b = k >> 1; pos = (k & 1) ? 511 - cx.bid : cx.bid; } else { b = it >> 9; pos = it & 511; }
        const int q0 = pos * 8, nch = (q0 >> 6) + 1, ntile = 2 * nch;
        {
            const int qA = q0 + 2 * pair + ((rho >> 2) & 1), headA = (rho & 3) + 4 * (rho >> 3);
            const bf16_t* qip = P2 + (size_t)(b * T + qA) * P2_LD + P2_QI + headA * 128 + 8 * hA;
            bf16x8 af[8];
#pragma unroll
            for (int s = 0; s < 8; ++s) af[s] = *(const bf16x8*)(qip + 16 * s);
            const float* wp = WI + (size_t)(b * T + q0 + 2 * pair + hA) * 16;
            f32x4 w4[4];
#pragma unroll
            for (int i = 0; i < 4; ++i) w4[i] = *(const f32x4*)(wp + 4 * i);
            LAS float* sc = (LAS float*)lds + (2 * pair + hA) * 4096;
            LAS unsigned char* stg = lds + 131072;
            const char* kub = (const char*)(KI + (size_t)(b * T) * 128);
            const unsigned kvo = (unsigned)(((cx.tid >> 4) * 128 + (cx.tid & 15) * 8) * 2);
#define KLD(TILE, HALF_) (*(const u32x4*)(kub + (size_t)(TILE) * 16384 + (size_t)(HALF_) * 8192 + kvo))
            const int sto = (cx.tid >> 4) * 272 + (cx.tid & 15) * 16;
            __builtin_amdgcn_s_waitcnt(0);
            u32x4 rA0 = KLD(0, 0), rA1 = KLD(0, 1), rB0 = rA0, rB1 = rA1;
            if (nch > 1) { rB0 = KLD(1, 0); rB1 = KLD(1, 1); }
            const LAS unsigned char* brd = stg + (kh * 32 + rho) * 272 + 16 * hA;
#define IDX_TILE(R0, R1, TILE) do { \
                __syncthreads(); \
                *(LAS u32x4*)(stg + sto) = R0; *(LAS u32x4*)(stg + sto + 32 * 272) = R1; \
                __syncthreads(); \
                if ((TILE) + 2 < nch) { R0 = KLD((TILE) + 2, 0); R1 = KLD((TILE) + 2, 1); } \
                bf16x8 bfr[8]; \
                _Pragma("unroll") for (int s = 0; s < 8; ++s) bfr[s] = *(const LAS bf16x8*)(brd + 32 * s); \
                f32x16 acc, acc2; \
                _Pragma("unroll") for (int i = 0; i < 16; ++i) { acc[i] = 0.f; acc2[i] = 0.f; } \
                _Pragma("unroll") for (int s = 0; s < 4; ++s) { acc = mfma32(af[2 * s], bfr[2 * s], acc); acc2 = mfma32(af[2 * s + 1], bfr[2 * s + 1], acc2); } \
                float v = 0.f, v2 = 0.f; \
                _Pragma("unroll") for (int i = 0; i < 16; i += 2) { v += w4[i >> 2][i & 3] * fmaxf(acc[i] + acc2[i], 0.f); v2 += w4[(i + 1) >> 2][(i + 1) & 3] * fmaxf(acc[i + 1] + acc2[i + 1], 0.f); } \
                v += v2; \
                sc[(TILE) * 64 + kh * 32 + rho] = v; } while (0)
            for (int tile = 0; tile < nch; tile += 2) {
                IDX_TILE(rA0, rA1, tile);
                if (tile + 1 < nch) IDX_TILE(rB0, rB1, tile + 1);
            }
#undef IDX_TILE
#undef KLD
        }
        __syncthreads();
        {
            const LAS unsigned* su = (const LAS unsigned*)lds + wave * 4096 + lane;
            unsigned u[64];
#pragma unroll
            for (int jj = 0; jj < 64; ++jj) { unsigned x = 0u; if (jj < nch) { const float sv_ = __builtin_bit_cast(float, su[jj * 64]);
                    const unsigned bits = (unsigned)__builtin_bit_cast(unsigned short, (_Float16)sv_) << 16; x = (bits & 0x80000000u) ? (~bits & 0xffff0000u) : (bits | 0x80000000u); } u[jj] = x; }
            int* ip = IDX + (size_t)(b * T + q0 + wave) * 256;
            if (nch <= 4) {
#pragma unroll
                for (int jj = 0; jj < 4; ++jj) ip[jj * 64 + lane] = (jj < nch) ? jj * 64 + lane : -1;
            } else {
                unsigned Tt = 0u;
                for (int bit = 31; bit >= 16; --bit) {
                    const unsigned cand = Tt | (1u << bit); int cnt = 0;
#pragma unroll
                    for (int g8 = 0; g8 < 8; ++g8) { if (g8 * 8 < nch) {
#pragma unroll
                        for (int jj = g8 * 8; jj < g8 * 8 + 8; ++jj) cnt += __builtin_popcountll(__ballot(u[jj] >= cand)); } }
                    if (cnt >= 256) Tt = cand;
                    if (cnt == 256) break;
                }
                int basep = 0;
#pragma unroll
                for (int jj = 0; jj < 64; ++jj) { if (jj >= nch) continue; const bool sel = u[jj] > Tt; const unsigned long long mk = __ballot(sel);
                    const int ps = basep + (int)__builtin_amdgcn_mbcnt_hi((unsigned)(mk >> 32), __builtin_amdgcn_mbcnt_lo((unsigned)mk, 0u));
                    if (sel) ip[ps] = jj * 64 + lane; basep += __builtin_popcountll(mk); }
#pragma unroll
                for (int jj = 0; jj < 64; ++jj) { if (jj >= nch) continue; const bool sel = u[jj] == Tt; const unsigned long long mk = __ballot(sel);
                    const int ps = basep + (int)__builtin_amdgcn_mbcnt_hi((unsigned)(mk >> 32), __builtin_amdgcn_mbcnt_lo((unsigned)mk, 0u));
                    if (sel && ps < 256) ip[ps] = jj * 64 + lane; basep += __builtin_popcountll(mk); }
            }
        }
        __syncthreads();
    }
}

constexpr int AT_ROWB = 528, AT_WAVEB = 32 * AT_ROWB, AT_BIAS = 8 * AT_WAVEB;
__device__ __forceinline__ s16x4 ld_tr(const LAS unsigned char* ptr) { return __builtin_bit_cast(s16x4, __builtin_amdgcn_ds_read_tr16_b64_v4i16((LAS s16x4*)ptr)); }
__device__ __forceinline__ int att_tok(const Ctx& cx, int k, int wloc) {
    if (cx.G == 256) return (k < 8) ? ((cx.bid & 7) >> 1) * T + k * 512 + wloc : -1;
    const int tok = cx.bid * 8 + cx.wave + k * cx.G * 8; return tok < M ? tok : -1;
}
#define ATT_GATHER(IR, SBLO, BB) do { const bf16_t* cb_ = CN + (size_t)(BB) * T * 256 + (lane & 31) * 8; _Pragma("unroll") for (int i_ = 0; i_ < 16; ++i_) { const int kidx_ = __shfl((IR), 32 * (SBLO) + 2 * i_ + (lane >> 5)); const unsigned kk_ = kidx_ < 0 ? 0u : (unsigned)kidx_; \
        g[i_] = *(const u32x4*)(cb_ + kk_ * 256u); if ((i_ & 3) == 3) asm volatile("" ::: "memory"); } } while (0)
__device__ __forceinline__ void dsa_attn_phase(const Params& p, const Ctx& cx, LAS unsigned char* lds) {
    const int wave = cx.wave, lane = cx.lane;
    const bf16_t* P2 = (const bf16_t*)(cx.ws + WS_P); const bf16_t* CN = (const bf16_t*)(cx.ws + WS_CN); const int* IDX = (const int*)(cx.ws + WS_IDX); bf16_t* OB = (bf16_t*)(cx.ws + WS_OB);
    LAS float* lb = (LAS float*)(lds + AT_BIAS);
    for (int e_ = cx.tid; e_ < 256 * 16; e_ += 512) { const int rel = (e_ >> 4) - 128, hd = e_ & 15, n = rel < 0 ? -rel : rel;
        const int large = 8 + (n >= 12) + (n >= 16) + (n >= 23) + (n >= 32) + (n >= 46) + (n >= 64) + (n >= 91);
        const int bk = ((rel > 0) ? 16 : 0) + ((n < 8) ? n : large);
        lb[e_] = p.in[14][bk * 16 + hd]; }
    __syncthreads();
    LAS unsigned char* wl = lds + wave * AT_WAVEB;
    const int fr = lane & 15, fq = lane >> 4;
    const int wloc = ((cx.bid & 1) * 32 + (cx.bid >> 3)) * 8 + wave;
    int tok = att_tok(cx, 0, wloc);
    int ir0 = 0, ir1 = 0, ir2 = 0, ir3 = 0;
    u32x4 g[16];
    if (tok >= 0) { const int* ip = IDX + (size_t)tok * 256 + lane; ir0 = ip[0]; ir1 = ip[64]; ir2 = ip[128]; ir3 = ip[192]; }
    for (int k = 0; tok >= 0; ++k) {
        const int b = tok >> 12, t = tok & (T - 1);
        const int ntok = att_tok(cx, k + 1, wloc);
        int nr0 = 0, nr1 = 0, nr2 = 0, nr3 = 0;
        if (ntok >= 0) { const int* ip = IDX + (size_t)ntok * 256 + lane; nr0 = ip[0]; nr1 = ip[64]; nr2 = ip[128]; nr3 = ip[192]; }
        const bf16_t* qp = P2 + (size_t)tok * P2_LD + P2_Q + fr * 256 + 8 * fq;
        float m_run = -INFINITY, l_run = 0.f;
        f32x4 oacc[16];
#pragma unroll
        for (int i = 0; i < 16; ++i) oacc[i] = (f32x4){0.f, 0.f, 0.f, 0.f};
        for (int sb = 0; sb < 8; ++sb) {
            const int h2 = sb >> 1, irc = (h2 == 0) ? ir0 : (h2 == 1) ? ir1 : (h2 == 2) ? ir2 : ir3;
            ATT_GATHER(irc, sb & 1, b);
#pragma unroll
            for (int i = 0; i < 16; ++i) *(LAS u32x4*)(wl + (2 * i + (lane >> 5)) * AT_ROWB + (lane & 31) * 16) = g[i];
            int kx[8];
#pragma unroll
            for (int e = 0; e < 8; ++e) kx[e] = __shfl(irc, 32 * (sb & 1) + 16 * (e >> 2) + 4 * fq + (e & 3));
            bf16x8 qf[8];
            { size_t qo_ = 0; asm volatile("" : "+s"(qo_));
#pragma unroll
              for (int s = 0; s < 8; ++s) qf[s] = *(const bf16x8*)(qp + qo_ + 32 * s); }
            asm volatile("s_waitcnt lgkmcnt(0)" ::: "memory");
            f32x4 sacc[2];
#pragma unroll
            for (int kt2 = 0; kt2 < 2; ++kt2) { f32x4 a = (f32x4){0.f, 0.f, 0.f, 0.f};
#pragma unroll
                for (int s = 0; s < 8; ++s) { const bf16x8 cf = *(const LAS bf16x8*)(wl + (16 * kt2 + fr) * AT_ROWB + (32 * s + 8 * fq) * 2); a = mfma16(cf, qf[s], a); if ((s & 3) == 3) asm volatile("" ::: "memory"); }
                sacc[kt2] = a; }
            float lg[8];
#pragma unroll
            for (int e = 0; e < 8; ++e) { const int kidx = kx[e]; const float a = ((e < 4) ? sacc[0][e & 3] : sacc[1][e & 3]) * 0.0625f;
                int rel = kidx - t; rel = rel < -128 ? -128 : (rel > 127 ? 127 : rel);
                const float bias = lb[(rel + 128) * 16 + fr];
                lg[e] = (kidx < 0) ? -INFINITY : a + bias; }
            float bm = fmaxf(fmaxf(fmaxf(lg[0], lg[1]), fmaxf(lg[2], lg[3])), fmaxf(fmaxf(lg[4], lg[5]), fmaxf(lg[6], lg[7])));
            bm = fmaxf(bm, __shfl_xor(bm, 16)); bm = fmaxf(bm, __shfl_xor(bm, 32));
            const float m_new = fmaxf(m_run, bm), scale = __expf(m_run - m_new);
            float pe[8], psum = 0.f;
#pragma unroll
            for (int e = 0; e < 8; ++e) { pe[e] = __expf(lg[e] - m_new); psum += pe[e]; }
            l_run = l_run * scale + psum; m_run = m_new;
#pragma unroll
            for (int i = 0; i < 16; ++i) oacc[i] = oacc[i] * scale;
            u32x4 pw; pw.x = pk2(pe[0], pe[1]); pw.y = pk2(pe[2], pe[3]); pw.z = pk2(pe[4], pe[5]); pw.w = pk2(pe[6], pe[7]);
            const bf16x8 pf = __builtin_bit_cast(bf16x8, pw);
            const LAS unsigned char* tb = wl + (4 * fq + ((lane & 15) >> 2)) * AT_ROWB + 8 * (lane & 3);
#pragma unroll
            for (int lt = 0; lt < 16; ++lt) {
                const s16x4 t0 = ld_tr(tb + 32 * lt), t1 = ld_tr(tb + 16 * AT_ROWB + 32 * lt);
                bf16x8 cf; cf[0] = t0[0]; cf[1] = t0[1]; cf[2] = t0[2]; cf[3] = t0[3]; cf[4] = t1[0]; cf[5] = t1[1]; cf[6] = t1[2]; cf[7] = t1[3];
                oacc[lt] = mfma16(cf, pf, oacc[lt]);
                if ((lt & 3) == 3) asm volatile("" ::: "memory");
            }
            asm volatile("s_waitcnt lgkmcnt(0)" ::: "memory");
        }
        float lt_ = l_run + __shfl_xor(l_run, 16); lt_ += __shfl_xor(lt_, 32);
        const float inv = 1.0f / lt_;
        bf16_t* op = OB + (size_t)tok * 4096 + fr * 256 + 4 * fq;
#pragma unroll
        for (int lt = 0; lt < 16; ++lt) { u32x2 w; w.x = pk2(oacc[lt][0] * inv, oacc[lt][1] * inv); w.y = pk2(oacc[lt][2] * inv, oacc[lt][3] * inv); *(u32x2*)(op + 16 * lt) = w; }
        tok = ntok; ir0 = nr0; ir1 = nr1; ir2 = nr2; ir3 = nr3;
    }
    __syncthreads();
}

#define XB_TMO      128
#define XB_XCNT(j)  (256  + 64 * (j))
#define XB_XSUB(j)  (1280 + 64 * (j))
#define XB_XGEN(j)  (2304 + 64 * (j))
#define XB_TOP      3328
#define XB_TOPGEN   3392
#define XCD_BAR_WORDS 3456
#define XB_SPIN_CAP (1u << 22)
__device__ __forceinline__ unsigned xb_ld(unsigned* p)              { return __hip_atomic_load(p, __ATOMIC_RELAXED, __HIP_MEMORY_SCOPE_AGENT); }
__device__ __forceinline__ unsigned xb_add(unsigned* p, unsigned v) { return __hip_atomic_fetch_add(p, v, __ATOMIC_RELAXED, __HIP_MEMORY_SCOPE_AGENT); }
__device__ __forceinline__ unsigned xb_xcc_id() { return (unsigned)__builtin_amdgcn_s_getreg((3 << 11) | 20) & 0xFu; }
#define XB_SPIN(cond, bar) do { unsigned _sp = 0; while (cond) { __builtin_amdgcn_s_sleep(1); \
    if ((++_sp & 255u) == 0u) { if (xb_ld(&(bar)[XB_TMO])) break; if (_sp > XB_SPIN_CAP) { atomicAdd(&(bar)[XB_TMO], 1u); break; } } } } while (0)
struct XcdBarrier { unsigned* bar; unsigned x; volatile LAS unsigned* st; };
__device__ __forceinline__ XcdBarrier xcd_barrier_post(unsigned* bar, volatile LAS unsigned* st) {
    XcdBarrier b; b.bar = bar; b.x = xb_xcc_id(); b.st = st;
    if (threadIdx.x == 0) (void)xb_add(&bar[XB_XCNT(b.x)], 1u);
    return b;
}
__device__ __forceinline__ void xcd_barrier_complete(unsigned* bar, unsigned x, unsigned& nloc, unsigned& nx) {
    const unsigned G = gridDim.x * gridDim.y * gridDim.z;
    unsigned sum, cnt, mine, sp = 0u;
    for (;;) {
        sum = 0u; cnt = 0u; mine = 0u;
#pragma unroll
        for (unsigned j = 0; j < 16; ++j) { const unsigned c = xb_ld(&bar[XB_XCNT(j)]); sum += c; cnt += (c > 0u) ? 1u : 0u; mine = (j == x) ? c : mine; }
        if (sum == G) break;
        __builtin_amdgcn_s_sleep(1);
        if ((++sp & 255u) == 0u) { if (xb_ld(&bar[XB_TMO])) break; if (sp > XB_SPIN_CAP) { atomicAdd(&bar[XB_TMO], 1u); break; } }
    }
    nloc = mine > 0u ? mine : 1u; nx = cnt > 0u ? cnt : 1u;
}
__device__ __forceinline__ void xcd_barrier(const XcdBarrier& b) {
    asm volatile("s_waitcnt vmcnt(0)" ::: "memory");
    __syncthreads();
    if (threadIdx.x == 0) {
        unsigned* bar = b.bar;
        __builtin_amdgcn_s_waitcnt(0);
        unsigned nloc = b.st[0], nx = b.st[1];
        if (nloc == 0u) { xcd_barrier_complete(bar, b.x, nloc, nx); b.st[0] = nloc; b.st[1] = nx; }
        const unsigned old = xb_add(&bar[XB_XSUB(b.x)], 1u);
        const unsigned gen = old / nloc;
        if (old + 1u == (gen + 1u) * nloc) {
            __builtin_amdgcn_fence(__ATOMIC_RELEASE, "agent");
            asm volatile("s_waitcnt vmcnt(0)" ::: "memory");
            const unsigned og = xb_add(&bar[XB_TOP], 1u);
            const unsigned tg = og / nx;
            if (og + 1u == (tg + 1u) * nx) xb_add(&bar[XB_TOPGEN], 1u);
            else XB_SPIN(xb_ld(&bar[XB_TOPGEN]) == tg, bar);
            __builtin_amdgcn_fence(__ATOMIC_ACQUIRE, "agent");
            xb_add(&bar[XB_XGEN(b.x)], 1u);
            asm volatile("s_waitcnt vmcnt(0)" ::: "memory");
        } else {
            XB_SPIN(xb_ld(&bar[XB_XGEN(b.x)]) == gen, bar);
            __builtin_amdgcn_fence(__ATOMIC_ACQUIRE, "agent");
            asm volatile("s_waitcnt vmcnt(0)" ::: "memory");
        }
    }
    __syncthreads();
}

constexpr int N_PHASES = 42;
__host__ __device__ inline bool phase_is_nop(int ph) { if (ph == 0 || ph == 41) return false; const int L = (ph - 1) / 10, s = (ph - 1) % 10; return (L == 0 && s == 0) || ((!(L & 1)) && s == 6); }

__host__ __device__ inline int phase_kind(int ph) {
    if (ph == 0) return 0; if (ph == 41) return 1;
    const int L = (ph - 1) / 10, s = (ph - 1) % 10; const bool gla = !(L & 1);
    if (s == 0 || s == 7) return 1; if (s == 1 || (!gla && s == 5)) return 2; if ((gla && s == 5) || (!gla && s == 6) || s == 9) return 3; if (s == 8) return 4;
    if (gla) return 3 + s; return 6 + s;
}
__global__ void __launch_bounds__(512, 2) trunk_fwd(Params p) {
    extern __shared__ __attribute__((aligned(16))) unsigned char smem[];
    LAS unsigned char* lds = (LAS unsigned char*)smem;
    volatile LAS unsigned* bst = (volatile LAS unsigned*)(lds + LDS_CTL);
    if (threadIdx.x < 64) bst[threadIdx.x] = 0u;
    __syncthreads();
    XcdBarrier gbar = xcd_barrier_post((unsigned*)p.ws, bst);
    if (p.ph_lo > 1000) cg::this_grid().sync();
    for (int ph = p.ph_lo, rep_ = 0; ph < p.ph_hi;) {
        if (phase_is_nop(ph)) { ++ph; continue; }
        int b_ = blockIdx.x; asm volatile("" : "+s"(b_)); int g_ = gridDim.x; asm volatile("" : "+s"(g_));
        size_t z_ = 0; asm volatile("" : "+s"(z_)); unsigned char* ws = p.ws + z_;
#define MKCX Ctx cx; { int t_ = threadIdx.x; asm volatile("" : "+v"(t_)); cx.tid = t_; cx.lane = t_ & 63; cx.wave = __builtin_amdgcn_readfirstlane(t_ >> 6); cx.bid = b_; cx.G = g_; cx.ws = ws; }
        bf16_t* Hb = (bf16_t*)(ws + WS_H); bf16_t* Pb = (bf16_t*)(ws + WS_P); bf16_t* XRp = (bf16_t*)(ws + WS_XR); const float* RSk = (const float*)(ws + WS_RSTD);
        if (ph == 0) { if (PHON(0)) { MKCX; prologue_phase(p, cx, lds); } }
        else if (ph == 41) { if (PHON(1)) { MKCX; rms_phase<true, true>(ws + WS_XR, p.in[3], p.out, cx); } }
        else {
            const int L = (ph - 1) / 10, s = (ph - 1) % 10, j = L >> 1; const bool gla = !(L & 1);
            unsigned char* wg = ws + WS_W + j * GLA_STRIDE; unsigned char* wd = ws + DSA_BASE + j * DSA_STRIDE; unsigned char* wf = ws + FFN_BASE + L * FFN_STRIDE;
            if (s == 0) { if (PHON(1)) { MKCX; rstd_phase(cx); } }
            else if (s == 7) { if (PHON(1)) { MKCX; rstd_phase(cx); } }
            else if (s == 1 || (!gla && s == 5)) {
                const int ng = (gla && s == 1) ? 2 : 1;
                for (int gi = 0; gi < ng; ++gi) {
                    pg8::Gemm g; pg8::EpiStore E;
                    if (gla) {
                        if (gi == 0) { g = pg8::Gemm{XRp, (const bf16_t*)(wg + GLA_WINA), M, 4096, D, D, D, 0}; E = pg8::EpiStore{Pb, P1_LD, RSk}; }
                        else { g = pg8::Gemm{(const bf16_t*)(wg + GLA_WV), XRp, D, M, D, D, D, 0}; E = pg8::EpiStore{(bf16_t*)(ws + WS_VT), M, nullptr}; }
                    } else if (s == 1) { g = pg8::Gemm{XRp, (const bf16_t*)(wd + DSA_WIN), M, P2_LD, D, D, D, 0}; E = pg8::EpiStore{Pb, P2_LD, RSk}; }
                    else { g = pg8::Gemm{(const bf16_t*)(ws + WS_OB), (const bf16_t*)(wd + DSA_WUV), M, D, 512, 4096, 512, 512}; E = pg8::EpiStore{Hb, D, nullptr}; }
                    pg8::StaticOrder S; S.init(g.M, g.N, g_, b_); int t2_ = threadIdx.x; asm volatile("" : "+v"(t2_));
                    if (PHON(2)) pg8::gemm_phase(lds, g, S, E, t2_);
                }
            } else if ((gla && s == 5) || (!gla && s == 6) || s == 9) {
                pg8::Gemm g;
                if (s == 9) g = pg8::Gemm{Pb, (const bf16_t*)(wf + FFN_W2), M, D, FF, FF, FF, 0};
                else g = pg8::Gemm{Hb, (const bf16_t*)(gla ? wg + GLA_WOUT : wd + DSA_WOUT), M, D, D, D, D, 0};
                pg8::EpiResid E{XRp, (float*)(ws + WS_SS)};
                pg8::StaticOrder S; S.init(g.M, g.N, g_, b_); int t2_ = threadIdx.x; asm volatile("" : "+v"(t2_));
                if (PHON(3)) pg8::gemm_phase(lds, g, S, E, t2_);
            } else if (s == 8) {
                pg8::Gemm g{XRp, (const bf16_t*)(wf + FFN_W13), M, 2 * FF, D, D, D, 0};
                pg8::EpiSwiglu E{Pb, RSk};
                pg8::StaticOrder S; S.init(g.M, g.N, g_, b_); int t2_ = threadIdx.x; asm volatile("" : "+v"(t2_));
                if (PHON(4)) pg8::gemm_phase(lds, g, S, E, t2_);
            } else if (gla) {
                if (s == 2) { if (PHON(5)) { MKCX; gla_gate_phase(p, cx, j, lds); } }
                else if (s == 3) { if (PHON(6)) { MKCX; gla_scan_phase(p, cx, lds); } }
                else if (s == 4) { if (PHON(7)) { MKCX; gla_normgate_phase(p, cx, j); } }
            } else {
                if (s == 2) { if (PHON(8)) { MKCX; dsa_post_phase(p, cx, j); } }
                else if (s == 3) { if (PHON(9)) { MKCX; dsa_index_phase(p, cx, lds); } }
                else if (s == 4) { if (PHON(10)) { MKCX; dsa_attn_phase(p, cx, lds); } }
            }
        }
        if (ph + 1 < p.ph_hi) { xcd_barrier(gbar); if ((REP_MASK >> 11) & 1) xcd_barrier(gbar); }
        if (REP_MASK && rep_ == 0 && phase_kind(ph) != 3 && ((REP_MASK >> phase_kind(ph)) & 1)) rep_ = 1; else { rep_ = 0; ++ph; }
    }
}

extern "C" void kernel_launch(void* const* d_in, const int* in_sizes, int n_in, void* d_out, int out_size, void* d_ws, size_t ws_size, hipStream_t stream) {
    static int grid = 0;
    if (!grid) {
        if (n_in != 18 || out_size != M * D || ws_size < WS_END) { fprintf(stderr, "kernel_launch: unexpected shapes (n_in %d out %d ws %zu)\n", n_in, out_size, ws_size); grid = -1; return; }
        int dev = 0, cus = 0, per_cu = 0;
        hipGetDevice(&dev); hipDeviceGetAttribute(&cus, hipDeviceAttributeMultiprocessorCount, dev);
        if (hipFuncSetAttribute((const void*)trunk_fwd, hipFuncAttributeMaxDynamicSharedMemorySize, LDS_BYTES) != hipSuccess) { fprintf(stderr, "kernel_launch: hipFuncSetAttribute failed\n"); grid = -1; return; }
        hipOccupancyMaxActiveBlocksPerMultiprocessor(&per_cu, (const void*)trunk_fwd, 512, LDS_BYTES);
        if (per_cu < 1) per_cu = 1;
        grid = cus * per_cu;
        fprintf(stderr, "kernel_launch: grid %d (cus %d x %d)\n", grid, cus, per_cu);
    }
    if (grid < 0) return;
    if (hipMemsetAsync(d_ws, 0, XCD_BAR_WORDS * 4, stream) != hipSuccess) { fprintf(stderr, "kernel_launch: memset failed\n"); return; }
    Params p{};
    for (int i = 0; i < 18; ++i) p.in[i] = (const float*)d_in[i];
    p.out = (float*)d_out; p.ws = (unsigned char*)d_ws;
#if MK_MULTI
    for (int ph = 0; ph < N_PHASES; ++ph) {
        if (phase_is_nop(ph)) continue;
        p.ph_lo = ph; p.ph_hi = ph + 1;
        hipLaunchKernelGGL(trunk_fwd, dim3(grid), dim3(512), LDS_BYTES, stream, p);
    }
#else
    p.ph_lo = 0; p.ph_hi = N_PHASES;
    void* args[] = {&p};
    hipError_t e = hipLaunchCooperativeKernel((const void*)trunk_fwd, dim3(grid), dim3(512), args, LDS_BYTES, stream);
    if (e != hipSuccess) fprintf(stderr, "cooperative launch failed: %s (grid %d)\n", hipGetErrorString(e), grid);
#endif
}
```

```cpp
#include <hip/hip_runtime.h>
#include <hip/hip_cooperative_groups.h>
#include <cstdio>
#include <cstdint>
namespace cg = cooperative_groups;

#ifndef PH_MASK
#define PH_MASK 0xFFFF
#endif
#define PHON(k) ((PH_MASK >> (k)) & 1)
#ifndef REP_MASK
#define REP_MASK 0
#endif
#ifndef MK_MULTI
#define MK_MULTI 0
#endif

#define LAS __attribute__((address_space(3)))
typedef unsigned short bf16_t;
typedef short bf16x8 __attribute__((ext_vector_type(8)));
typedef short s16x4 __attribute__((ext_vector_type(4)));
typedef float f32x4 __attribute__((ext_vector_type(4)));
typedef float f32x16 __attribute__((ext_vector_type(16)));
typedef unsigned u32x4 __attribute__((ext_vector_type(4)));
typedef unsigned u32x2 __attribute__((ext_vector_type(2)));
typedef int i32x4 __attribute__((ext_vector_type(4)));

constexpr int NB = 4, T = 4096, M = NB * T, D = 2048, FF = 5632;
constexpr int P1_LD = 4352, P1_Q = 0, P1_K = 1024, P1_G = 2048, P1_A = 4096;
constexpr int P2_LD = 6656, P2_Q = 0, P2_C = 4096, P2_QI = 4352, P2_KI = 6400, P2_WI = 6528;
constexpr float RMS_EPS = 1e-6f;

constexpr size_t MiB = 1u << 20;
constexpr size_t WS_W = 1 * MiB;
constexpr size_t GLA_STRIDE = 33 * MiB, GLA_WINA = 0, GLA_WV = 17 * MiB, GLA_WOUT = 25 * MiB;
constexpr size_t DSA_BASE = WS_W + 66 * MiB, DSA_STRIDE = 36 * MiB, DSA_WIN = 0, DSA_WUV = 26 * MiB, DSA_WOUT = 28 * MiB;
constexpr size_t FFN_BASE = WS_W + 138 * MiB, FFN_STRIDE = 66 * MiB, FFN_W13 = 0, FFN_W2 = 44 * MiB;
constexpr size_t WS_H = 403 * MiB, WS_P = 467 * MiB, WS_VT = 603 * MiB, WS_X2 = 675 * MiB;
constexpr size_t WS_KDT = WS_X2, WS_DEC = WS_X2 + 32 * MiB, WS_O = WS_X2 + 33 * MiB;
constexpr size_t WS_CN = WS_X2, WS_KI = WS_X2 + 8 * MiB, WS_WI = WS_X2 + 12 * MiB, WS_IDX = WS_X2 + 13 * MiB, WS_OB = WS_X2 + 29 * MiB;
constexpr size_t WS_XR = 832 * MiB;
constexpr size_t WS_RSTD = 896 * MiB, WS_SS = 897 * MiB;
constexpr size_t WS_END = 900 * MiB;
constexpr int LDS_BYTES = 163840, LDS_CTL = 163584;

struct Params { const float* in[18]; float* out; unsigned char* ws; int ph_lo, ph_hi; };
struct Ctx { int tid, lane, wave, bid, G; unsigned char* ws; };

__device__ __forceinline__ float bf2f(bf16_t u) { return __builtin_bit_cast(float, (unsigned)u << 16); }
__device__ __forceinline__ float bflo(unsigned u) { return __builtin_bit_cast(float, u << 16); }
__device__ __forceinline__ float bfhi(unsigned u) { return __builtin_bit_cast(float, u & 0xffff0000u); }
typedef __bf16 bf16x2_t __attribute__((ext_vector_type(2)));
typedef float f32x2_t __attribute__((ext_vector_type(2)));
__device__ __forceinline__ unsigned pk2(float lo, float hi) { const f32x2_t v = {lo, hi}; const bf16x2_t b = __builtin_convertvector(v, bf16x2_t); return __builtin_bit_cast(unsigned, b); }
__device__ __forceinline__ float wave_sum(float v) {
#pragma unroll
    for (int o = 1; o < 64; o <<= 1) v += __shfl_xor(v, o);
    return v;
}
__device__ __forceinline__ f32x4 mfma16(bf16x8 a, bf16x8 b, f32x4 c) { return __builtin_amdgcn_mfma_f32_16x16x32_bf16(a, b, c, 0, 0, 0); }
__device__ __forceinline__ f32x16 mfma32(bf16x8 a, bf16x8 b, f32x16 c) { return __builtin_amdgcn_mfma_f32_32x32x16_bf16(a, b, c, 0, 0, 0); }

namespace pg8 {
constexpr int BM = 256, BK = 64, HALF = 128, HTB = HALF * BK * 2, STAGE_BYTES = 8 * HTB, NXCD = 8, WGM = 8;
__host__ __device__ __forceinline__ int lds_byte(int r, int c) { const int st = (r >> 4) * 2 + (c >> 5), rr = r & 15, cc = c & 31, ob = rr * 64 + cc * 2; return st * 1024 + (ob ^ (((ob >> 9) & 1) << 5)); }
__host__ __device__ __forceinline__ void stage_rc(int b, int& R, int& C) { const int st = b / 1024, sb = b % 1024, swz = sb ^ (((sb >> 9) & 1) << 5); R = (st >> 1) * 16 + swz / 64; C = (st & 1) * 32 + (swz % 64) / 2; }
__host__ __device__ __forceinline__ int perm32(int rho) { const int n = rho >> 4, i = rho & 15; return 8 * (i >> 2) + 4 * n + (i & 3); }

struct Unit { int pm, pn; };
struct Gemm { const bf16_t* A; const bf16_t* Bt; int M, N, K, lda, ldb, apn; };

struct StaticOrder {
    int nM, nN, nwg, G, c;
    __device__ void init(int M_, int N_, int G_, int c_) { nM = M_ / BM; nN = N_ / BM; nwg = nM * nN; G = G_; c = c_; }
    __device__ bool next(int i, Unit& u) const {
        const long L = (long)i * G + c; if (L >= nwg) return false;
        int wgid = (int)L; { const int q = nwg / NXCD, r = nwg % NXCD, xcd = wgid % NXCD, off = wgid / NXCD; wgid = (xcd < r ? xcd * (q + 1) : r * (q + 1) + (xcd - r) * q) + off; }
        const int nig = WGM * nN, gid = wgid / nig, fm = gid * WGM, gsz = (nM - fm) < WGM ? (nM - fm) : WGM;
        u.pm = fm + ((wgid % nig) % gsz); u.pn = (wgid % nig) / gsz; return true;
    }
};

struct EpiStore {
    bf16_t* O; int ldc; const float* rstd;
    __device__ __forceinline__ void operator()(const f32x4 (&acc)[2][2][4][2], const Unit& u, int wr, int wc, int fr, int fq) const {
        const int row0 = u.pm * BM + wr * 64 + fr, col0 = u.pn * BM + wc * 32 + 8 * fq;
        float rs[2][4];
#pragma unroll
        for (int ai = 0; ai < 2; ++ai)
#pragma unroll
            for (int m = 0; m < 4; ++m) rs[ai][m] = rstd ? rstd[row0 + ai * HALF + m * 16] : 1.0f;
#pragma unroll
        for (int ai = 0; ai < 2; ++ai)
#pragma unroll
            for (int m = 0; m < 4; ++m) { bf16_t* rowp = O + (size_t)(row0 + ai * HALF + m * 16) * ldc + col0;
#pragma unroll
                for (int bj = 0; bj < 2; ++bj) { const f32x4 v0 = acc[ai][bj][m][0] * rs[ai][m], v1 = acc[ai][bj][m][1] * rs[ai][m];
                    u32x4 w; w.x = pk2(v0[0], v0[1]); w.y = pk2(v0[2], v0[3]); w.z = pk2(v1[0], v1[1]); w.w = pk2(v1[2], v1[3]);
                    *(u32x4*)(rowp + bj * HALF) = w; } }
    }
};
struct EpiResid {
    bf16_t* xr; float* ss;
    __device__ __forceinline__ void operator()(const f32x4 (&acc)[2][2][4][2], const Unit& u, int wr, int wc, int fr, int fq) const {
        const int row0 = u.pm * BM + wr * 64 + fr, col0 = u.pn * BM + wc * 32 + 8 * fq;
#pragma unroll
        for (int ai = 0; ai < 2; ++ai)
#pragma unroll
            for (int m = 0; m < 4; ++m) { const int row = row0 + ai * HALF + m * 16; const size_t ro = (size_t)row * D + col0; float sq = 0.f;
#pragma unroll
                for (int bj = 0; bj < 2; ++bj) { const u32x4 xv = *(const u32x4*)(xr + ro + bj * HALF);
                    const f32x4 a0 = (f32x4){bflo(xv.x), bfhi(xv.x), bflo(xv.y), bfhi(xv.y)}, a1 = (f32x4){bflo(xv.z), bfhi(xv.z), bflo(xv.w), bfhi(xv.w)};
                    const f32x4 o0 = a0 + acc[ai][bj][m][0], o1 = a1 + acc[ai][bj][m][1];
                    u32x4 w; w.x = pk2(o0[0], o0[1]); w.y = pk2(o0[2], o0[3]); w.z = pk2(o1[0], o1[1]); w.w = pk2(o1[2], o1[3]);
                    *(u32x4*)(xr + ro + bj * HALF) = w;
                    sq += ((o0[0] * o0[0] + o0[1] * o0[1]) + (o0[2] * o0[2] + o0[3] * o0[3])) + ((o1[0] * o1[0] + o1[1] * o1[1]) + (o1[2] * o1[2] + o1[3] * o1[3])); }
                sq += __shfl_xor(sq, 16); sq += __shfl_xor(sq, 32);
                if (fq == 0) ss[(size_t)row * 32 + u.pn * 4 + wc] = sq; }
    }
};
struct EpiSwiglu {
    bf16_t* U; const float* rstd;
    __device__ __forceinline__ void operator()(const f32x4 (&acc)[2][2][4][2], const Unit& u, int wr, int wc, int fr, int fq) const {
        const int row0 = u.pm * BM + wr * 64 + fr, col0 = u.pn * 128 + wc * 16 + 4 * fq;
        float rs[2][4];
#pragma unroll
        for (int ai = 0; ai < 2; ++ai)
#pragma unroll
            for (int m = 0; m < 4; ++m) rs[ai][m] = rstd[row0 + ai * HALF + m * 16];
#pragma unroll
        for (int ai = 0; ai < 2; ++ai)
#pragma unroll
            for (int m = 0; m < 4; ++m) { bf16_t* rowp = U + (size_t)(row0 + ai * HALF + m * 16) * FF + col0;
#pragma unroll
                for (int bj = 0; bj < 2; ++bj) { const f32x4 g = acc[ai][bj][m][0] * rs[ai][m], v = acc[ai][bj][m][1] * rs[ai][m]; float o[4];
#pragma unroll
                    for (int i = 0; i < 4; ++i) { const float e = __builtin_amdgcn_exp2f(-1.44269504089f * g[i]); o[i] = g[i] * __builtin_amdgcn_rcpf(1.0f + e) * v[i]; }
                    u32x2 w; w.x = pk2(o[0], o[1]); w.y = pk2(o[2], o[3]);
                    *(u32x2*)(rowp + bj * 64) = w; } }
    }
};

template <class Epi, class Sched>
__device__ __forceinline__ void gemm_phase(LAS unsigned char* lds, const Gemm g, const Sched& S, const Epi& E, const int tid) {
    const int wid = __builtin_amdgcn_readfirstlane(tid >> 6), lane = tid & 63, wr = wid >> 2, wc = wid & 3, fr = lane & 15, fq = lane >> 4;
    const int K = g.K, nt = K / BK;
    unsigned voffA[2], voffB[2];
#pragma unroll
    for (int i = 0; i < 2; ++i) { int R, C; stage_rc(tid * 16 + i * 8192, R, C); const int Rb = (R & ~31) + perm32(R & 31);
        voffA[i] = (unsigned)(R * g.lda + C) * 2u; voffB[i] = (unsigned)(Rb * g.ldb + C) * 2u; }
    const size_t kstep = (size_t)(BK * 2);
    const size_t hstepA = (size_t)HALF * g.lda * 2, hstepB = (size_t)HALF * g.ldb * 2;
    const size_t tstepA = 2 * hstepA, tstepB = 2 * hstepB, pnA = (size_t)g.apn * 2;
    const unsigned ldsw = (unsigned)wid * 1024u;
    const int aoff = lds_byte(wr * 64 + fr, fq * 8), boff = lds_byte(wc * 32 + fr, fq * 8);
#define PG8_SA(b, h) (((b) * 2 + (h)) * HTB)
#define PG8_SB(b, h) ((4 + (b) * 2 + (h)) * HTB)
#define PG8_STAGE(bufoff, gbase, voff) do { _Pragma("unroll") for (int _i = 0; _i < 2; ++_i) \
        __builtin_amdgcn_global_load_lds((const unsigned*)((const char*)(gbase) + (voff)[_i]), (LAS unsigned*)(lds + (bufoff) + ldsw + _i * 8192), 16, 0, 0); } while (0)
#define PG8_LDA(dst, b, h) do { _Pragma("unroll") for (int m = 0; m < 4; ++m) _Pragma("unroll") for (int k = 0; k < 2; ++k) dst[m][k] = *(const LAS bf16x8*)(lds + PG8_SA(b, h) + aoff + m * 2048 + k * 1024); } while (0)
#define PG8_LDB(dst, b, h) do { _Pragma("unroll") for (int n = 0; n < 2; ++n) _Pragma("unroll") for (int k = 0; k < 2; ++k) dst[n][k] = *(const LAS bf16x8*)(lds + PG8_SB(b, h) + boff + n * 2048 + k * 1024); } while (0)
#define PG8_MMA(ai, bj, At, Bt) do { __builtin_amdgcn_s_setprio(1); _Pragma("unroll") for (int m = 0; m < 4; ++m) _Pragma("unroll") for (int n = 0; n < 2; ++n) _Pragma("unroll") for (int k = 0; k < 2; ++k) \
        acc[ai][bj][m][n] = __builtin_amdgcn_mfma_f32_16x16x32_bf16(Bt[n][k], At[m][k], acc[ai][bj][m][n], 0, 0, 0); __builtin_amdgcn_s_setprio(0); } while (0)
#define PG8_WAIT_V(n) asm volatile("s_waitcnt vmcnt(" #n ")" ::: "memory")
#define PG8_WAIT_L(n) asm volatile("s_waitcnt lgkmcnt(" #n ")" ::: "memory")
#define PG8_BAR __builtin_amdgcn_s_barrier()
#define PG8_SCHED __builtin_amdgcn_sched_barrier(0)
    Unit cur, nxt; int ui = 0;
    if (!S.next(0, cur)) return;
    f32x4 acc[2][2][4][2];
#pragma unroll
    for (int a = 0; a < 2; ++a)
#pragma unroll
        for (int b = 0; b < 2; ++b)
#pragma unroll
            for (int m = 0; m < 4; ++m)
#pragma unroll
                for (int n = 0; n < 2; ++n) acc[a][b][m][n] = (f32x4){0.f, 0.f, 0.f, 0.f};
    bf16x8 At[4][2], B0[2][2], B1[2][2];
    const char* cA = (const char*)g.A + (size_t)cur.pm * tstepA + (size_t)cur.pn * pnA; const char* cB = (const char*)g.Bt + (size_t)cur.pn * tstepB;
    PG8_STAGE(PG8_SB(0, 0), cB, voffB); PG8_STAGE(PG8_SB(0, 1), cB + hstepB, voffB); PG8_STAGE(PG8_SA(0, 0), cA, voffA); PG8_STAGE(PG8_SA(0, 1), cA + hstepA, voffA);
    if (wr == 1) PG8_BAR;
    PG8_WAIT_V(2); PG8_BAR;
    PG8_STAGE(PG8_SB(1, 0), cB + kstep, voffB); PG8_STAGE(PG8_SA(1, 0), cA + kstep, voffA); PG8_STAGE(PG8_SB(1, 1), cB + hstepB + kstep, voffB);
    PG8_WAIT_V(6); PG8_BAR;
    for (;;) {
        const bool has_next = S.next(ui + 1, nxt);
        const char* nA = has_next ? (const char*)g.A + (size_t)nxt.pm * tstepA + (size_t)nxt.pn * pnA : cA; const char* nB = has_next ? (const char*)g.Bt + (size_t)nxt.pn * tstepB : cB;
        for (int t = 0; t < nt; t += 2) {
            const bool last = (t == nt - 2);
            const char* a1 = cA + (size_t)(t + 1) * kstep;
            const char* a2 = last ? nA : cA + (size_t)(t + 2) * kstep; const char* b2 = last ? nB : cB + (size_t)(t + 2) * kstep;
            const char* a3 = a2 + kstep; const char* b3 = b2 + kstep;
            PG8_LDB(B0, 0, 0); PG8_LDB(B1, 0, 1); PG8_SCHED; PG8_LDA(At, 0, 0); PG8_STAGE(PG8_SA(1, 1), a1 + hstepA, voffA);
            PG8_WAIT_V(8); PG8_WAIT_L(0); PG8_BAR; PG8_MMA(0, 0, At, B0); PG8_MMA(0, 1, At, B1); PG8_BAR; PG8_SCHED;
            PG8_LDA(At, 0, 1); PG8_STAGE(PG8_SB(0, 0), b2, voffB); PG8_STAGE(PG8_SB(0, 1), b2 + hstepB, voffB); PG8_STAGE(PG8_SA(0, 0), a2, voffA);
            PG8_WAIT_V(8); PG8_WAIT_L(0); PG8_BAR; PG8_MMA(1, 0, At, B0); PG8_MMA(1, 1, At, B1); PG8_BAR; PG8_SCHED;
            PG8_LDB(B0, 1, 0); PG8_LDB(B1, 1, 1); PG8_SCHED; PG8_LDA(At, 1, 0); PG8_STAGE(PG8_SA(0, 1), a2 + hstepA, voffA);
            PG8_WAIT_V(8); PG8_WAIT_L(0); PG8_BAR; PG8_MMA(0, 0, At, B0); PG8_MMA(0, 1, At, B1); PG8_BAR; PG8_SCHED;
            PG8_LDA(At, 1, 1); PG8_STAGE(PG8_SB(1, 0), b3, voffB); PG8_STAGE(PG8_SB(1, 1), b3 + hstepB, voffB); PG8_STAGE(PG8_SA(1, 0), a3, voffA);
            PG8_WAIT_V(8); PG8_WAIT_L(0); PG8_BAR; PG8_MMA(1, 0, At, B0); PG8_MMA(1, 1, At, B1); PG8_BAR; PG8_SCHED;
        }
        if (wr == 0) PG8_BAR;
        E(acc, cur, wr, wc, fr, fq);
        if (!has_next) break;
#pragma unroll
        for (int a = 0; a < 2; ++a)
#pragma unroll
            for (int b = 0; b < 2; ++b)
#pragma unroll
                for (int m = 0; m < 4; ++m)
#pragma unroll
                    for (int n = 0; n < 2; ++n) acc[a][b][m][n] = (f32x4){0.f, 0.f, 0.f, 0.f};
        cur = nxt; cA = nA; cB = nB; ++ui;
        if (wr == 1) PG8_BAR;
    }
    PG8_WAIT_V(0);
    PG8_BAR;
#undef PG8_SA
#undef PG8_SB
#undef PG8_STAGE
#undef PG8_LDA
#undef PG8_LDB
#undef PG8_MMA
#undef PG8_WAIT_V
#undef PG8_WAIT_L
#undef PG8_BAR
#undef PG8_SCHED
}
}

struct TrSeg { const float* W; int ldw, ncols, K; bf16_t* WT; int ldt, row_off, mode; const float* gain; };
__device__ __forceinline__ void tr_item(const TrSeg& s, int kb, int nb, LAS float* scr, int lane) {
    const int k0 = 64 * kb, n0 = 64 * nb;
    const int c4 = (lane & 15) * 4, kq = lane >> 4;
    const bool okc = (n0 + c4) < s.ncols;
    const float* src = s.W + (size_t)(k0 + kq) * s.ldw + n0 + c4;
    f32x4 v[16];
#pragma unroll
    for (int i = 0; i < 16; ++i) v[i] = okc ? __builtin_nontemporal_load((const f32x4*)(src + (size_t)(4 * i) * s.ldw)) : (f32x4){0.f, 0.f, 0.f, 0.f};
    if (s.gain) {
#pragma unroll
        for (int i = 0; i < 16; ++i) v[i] = v[i] * s.gain[k0 + 4 * i + kq]; }
#pragma unroll
    for (int i = 0; i < 16; ++i) { LAS float* d = scr + (4 * i + kq) * 65 + c4; d[0] = v[i][0]; d[1] = v[i][1]; d[2] = v[i][2]; d[3] = v[i][3]; }
    asm volatile("s_waitcnt lgkmcnt(0)" ::: "memory");
    const int c = lane & 7;
#pragma unroll
    for (int j = 0; j < 8; ++j) { const int n = (lane >> 3) + 8 * j, gn = n0 + n; const LAS float* sp = scr + (8 * c) * 65 + n;
        u32x4 o; o.x = pk2(sp[0 * 65], sp[1 * 65]); o.y = pk2(sp[2 * 65], sp[3 * 65]); o.z = pk2(sp[4 * 65], sp[5 * 65]); o.w = pk2(sp[6 * 65], sp[7 * 65]);
        const int row = s.mode ? (8 * (gn >> 2) + (gn & 3) + s.row_off) : (s.row_off + gn);
        if (gn < s.ncols) *(u32x4*)(s.WT + (size_t)row * s.ldt + k0 + 8 * c) = o; }
    asm volatile("s_waitcnt lgkmcnt(0)" ::: "memory");
}
__device__ __forceinline__ void tr_run(const TrSeg& s, int& next, int& base, int NGW, LAS float* scr, int lane) {
    const int nnb = (s.ncols + 63) >> 6, n = (s.K >> 6) * nnb;
    while (next < base + n) { const int it = next - base; tr_item(s, it / nnb, it % nnb, scr, lane); next += NGW; }
    base += n;
}
__device__ __forceinline__ void prologue_phase(const Params& p, const Ctx& cx, LAS unsigned char* lds, const int part) {
    const int wave = cx.wave, lane = cx.lane, G = cx.G, gw = cx.bid * 8 + wave, NGW = G * 8;
    LAS float* scr = (LAS float*)(lds + wave * 16640);
    unsigned char* ws = cx.ws;
    int next = gw, base = 0;
    for (int i = 3; i >= 0; --i) {
        if ((i >= 2) != (part == 1)) continue;
        bf16_t* W13 = (bf16_t*)(ws + FFN_BASE + i * FFN_STRIDE + FFN_W13); bf16_t* W2 = (bf16_t*)(ws + FFN_BASE + i * FFN_STRIDE + FFN_W2);
        { TrSeg s{p.in[15] + (size_t)i * D * FF, FF, FF, D, W13, D, 0, 1, p.in[2] + (size_t)i * D}; tr_run(s, next, base, NGW, scr, lane); }
        { TrSeg s{p.in[16] + (size_t)i * D * FF, FF, FF, D, W13, D, 4, 1, p.in[2] + (size_t)i * D}; tr_run(s, next, base, NGW, scr, lane); }
        { TrSeg s{p.in[17] + (size_t)i * FF * D, D, D, FF, W2, FF, 0, 0, nullptr}; tr_run(s, next, base, NGW, scr, lane); }
    }
    for (int j = 1; j >= 0; --j) {
        if ((j == 1) != (part == 1)) continue;
        bf16_t* Win = (bf16_t*)(ws + DSA_BASE + j * DSA_STRIDE + DSA_WIN); bf16_t* Wuv = (bf16_t*)(ws + DSA_BASE + j * DSA_STRIDE + DSA_WUV); bf16_t* Wo = (bf16_t*)(ws + DSA_BASE + j * DSA_STRIDE + DSA_WOUT);
        { TrSeg s{p.in[9] + (size_t)j * D * 6544, 6544, 6544, D, Win, D, 0, 0, p.in[1] + (size_t)(2 * j + 1) * D}; tr_run(s, next, base, NGW, scr, lane); }
        for (int h = 0; h < 16; ++h) {
            TrSeg s{p.in[12] + (size_t)(j * 16 + h) * 256 * 128, 128, 128, 256, Wuv + (size_t)((h >> 1) * 256 + (h & 1) * 128) * 512 + (h & 1) * 256, 512, 0, 0, nullptr};
            tr_run(s, next, base, NGW, scr, lane);
        }
        { TrSeg s{p.in[13] + (size_t)j * D * D, D, D, D, Wo, D, 0, 0, nullptr}; tr_run(s, next, base, NGW, scr, lane); }
        for (int i = cx.bid * 512 + cx.tid; i < 65536; i += G * 512) {
            const int blk = i >> 12, r = (i >> 5) & 127, ch = i & 31, pn = blk >> 1, hh = blk & 1;
            *(u32x4*)(Wuv + (size_t)(pn * 256 + hh * 128 + r) * 512 + (1 - hh) * 256 + ch * 8) = (u32x4){0u, 0u, 0u, 0u};
        }
    }
    for (int j = 1; j >= 0; --j) {
        if (part == 1) continue;
        const float* w_in = p.in[4] + (size_t)j * D * 6160;
        const float* gmix = p.in[1] + (size_t)(2 * j) * D;
        bf16_t* WinA = (bf16_t*)(ws + WS_W + j * GLA_STRIDE + GLA_WINA); bf16_t* Wv = (bf16_t*)(ws + WS_W + j * GLA_STRIDE + GLA_WV); bf16_t* Wo = (bf16_t*)(ws + WS_W + j * GLA_STRIDE + GLA_WOUT);
        { TrSeg s{w_in, 6160, 2048, D, WinA, D, 0, 0, gmix}; tr_run(s, next, base, NGW, scr, lane); }
        { TrSeg s{w_in + 2048, 6160, 2048, D, Wv, D, 0, 0, gmix}; tr_run(s, next, base, NGW, scr, lane); }
        { TrSeg s{w_in + 4096, 6160, 2048, D, WinA, D, 2048, 0, gmix}; tr_run(s, next, base, NGW, scr, lane); }
        { TrSeg s{w_in + 6144, 6160, 16, D, WinA, D, 4096, 0, gmix}; tr_run(s, next, base, NGW, scr, lane); }
        { TrSeg s{p.in[8] + (size_t)j * D * D, D, D, D, Wo, D, 0, 0, nullptr}; tr_run(s, next, base, NGW, scr, lane); }
    }
    bf16_t* XR = (bf16_t*)(ws + WS_XR); float* RS = (float*)(ws + WS_RSTD);
    for (int m = gw; m < M && part == 0; m += NGW) {
        const f32x4* xr = (const f32x4*)(p.in[0] + (size_t)m * D) + lane; u32x2* o = (u32x2*)(XR + (size_t)m * D) + lane; float sq = 0.f;
#pragma unroll
        for (int jq = 0; jq < 8; ++jq) { const f32x4 v = __builtin_nontemporal_load(xr + 64 * jq); sq += (v[0] * v[0] + v[1] * v[1]) + (v[2] * v[2] + v[3] * v[3]); u32x2 w; w.x = pk2(v[0], v[1]); w.y = pk2(v[2], v[3]); o[64 * jq] = w; }
        sq = wave_sum(sq);
        if (lane == 0) RS[m] = 1.0f / sqrtf(sq * (1.0f / D) + RMS_EPS);
    }
}

template <bool BF16IN, bool F32OUT>
__device__ __forceinline__ void rms_phase(const void* xp, const float* g, void* outp, const Ctx& cx) {
    const int lane = cx.lane, gw = cx.bid * 8 + cx.wave, NGW = cx.G * 8;
    f32x4 gv[8], nx[8];
#pragma unroll
    for (int j = 0; j < 8; ++j) gv[j] = ((const f32x4*)g)[lane + 64 * j];
#define RMS_LOAD(ROW) do { if (BF16IN) { const u32x2* xr_ = (const u32x2*)((const bf16_t*)xp + (size_t)(ROW) * D) + lane; \
            _Pragma("unroll") for (int j = 0; j < 8; ++j) { const u32x2 t_ = xr_[64 * j]; nx[j] = (f32x4){bflo(t_.x), bfhi(t_.x), bflo(t_.y), bfhi(t_.y)}; } } \
        else { const f32x4* xr_ = (const f32x4*)((const float*)xp + (size_t)(ROW) * D) + lane; _Pragma("unroll") for (int j = 0; j < 8; ++j) nx[j] = xr_[64 * j]; } } while (0)
    if (gw < M) RMS_LOAD(gw);
    for (int m = gw; m < M; m += NGW) {
        f32x4 v[8]; float s = 0.f;
#pragma unroll
        for (int j = 0; j < 8; ++j) v[j] = nx[j];
        if (m + NGW < M) RMS_LOAD(m + NGW);
#pragma unroll
        for (int j = 0; j < 8; ++j) s += (v[j][0] * v[j][0] + v[j][1] * v[j][1]) + (v[j][2] * v[j][2] + v[j][3] * v[j][3]);
        s = wave_sum(s);
        const float r = 1.0f / sqrtf(s * (1.0f / D) + RMS_EPS);
        if (F32OUT) { f32x4* o = (f32x4*)((float*)outp + (size_t)m * D) + lane;
#pragma unroll
            for (int j = 0; j < 8; ++j) o[64 * j] = v[j] * r * gv[j];
        } else { u32x2* o = (u32x2*)((bf16_t*)outp + (size_t)m * D) + lane;
#pragma unroll
            for (int j = 0; j < 8; ++j) { const f32x4 y = v[j] * r * gv[j]; u32x2 w; w.x = pk2(y[0], y[1]); w.y = pk2(y[2], y[3]); o[64 * j] = w; } }
    }
#undef RMS_LOAD
}
__device__ __forceinline__ void rstd_phase(const Ctx& cx) {
    const float* SS = (const float*)(cx.ws + WS_SS); float* RS = (float*)(cx.ws + WS_RSTD);
    for (int m = cx.bid * 512 + cx.tid; m < M; m += cx.G * 512) {
        const f32x4* sp = (const f32x4*)(SS + (size_t)m * 32); float t = 0.f;
#pragma unroll
        for (int q = 0; q < 8; ++q) { const f32x4 a = sp[q]; t += (a[0] + a[1]) + (a[2] + a[3]); }
        RS[m] = 1.0f / sqrtf(t * (1.0f / D) + RMS_EPS);
    }
}
__device__ __forceinline__ float fexp(float x) { return __builtin_amdgcn_exp2f(x * 1.44269504089f); }
__device__ __forceinline__ float log_sigmoid(float z) { return fminf(z, 0.f) - __builtin_amdgcn_logf(1.0f + fexp(-fabsf(z))) * 0.69314718056f; }
__device__ __forceinline__ void gla_gate_phase(const Params& p, const Ctx& cx, int j, LAS unsigned char* lds) {
    const bf16_t* P1 = (const bf16_t*)(cx.ws + WS_P); bf16_t* KDT = (bf16_t*)(cx.ws + WS_KDT); float* DEC = (float*)(cx.ws + WS_DEC);
    const bf16_t* H = (const bf16_t*)(cx.ws + WS_XR); const float* RS = (const float*)(cx.ws + WS_RSTD); const bf16_t* Wa = (const bf16_t*)(cx.ws + WS_W + (size_t)j * GLA_STRIDE + GLA_WINA) + (size_t)4096 * D;
    const float* w_a2 = p.in[5] + (size_t)j * 16 * 1024; const float* b_a = p.in[6] + (size_t)j * 1024;
    const int wave = cx.wave, lane = cx.lane, fr = lane & 15, fq = lane >> 4;
    LAS float* al = (LAS float*)(lds + 32768);
    for (int it = cx.bid; it < 512; it += cx.G) {
        const int bc = it >> 1, kcol = (it & 1) * 512 + cx.tid, b = bc >> 6, c = bc & 63, tok0 = b * T + c * 64;
        __syncthreads();
        {
            f32x4 acc[4];
#pragma unroll
            for (int tt = 0; tt < 4; ++tt) acc[tt] = (f32x4){0.f, 0.f, 0.f, 0.f};
            const bf16_t* hp = H + (size_t)(tok0 + fr) * D + 256 * wave + 8 * fq;
            const bf16_t* wp = Wa + (size_t)fr * D + 256 * wave + 8 * fq;
#pragma unroll
            for (int ss = 0; ss < 8; ++ss) { const bf16x8 bfg = *(const bf16x8*)(wp + 32 * ss);
#pragma unroll
                for (int tt = 0; tt < 4; ++tt) { const bf16x8 afg = *(const bf16x8*)(hp + (size_t)(16 * tt) * D + 32 * ss); acc[tt] = mfma16(afg, bfg, acc[tt]); } }
#pragma unroll
            for (int tt = 0; tt < 4; ++tt) *(LAS f32x4*)(lds + ((wave * 4 + tt) * 64 + lane) * 16) = acc[tt];
        }
        __syncthreads();
        if (cx.tid < 256) { const int tt = cx.tid >> 6, l2 = cx.tid & 63;
            f32x4 v = *(const LAS f32x4*)(lds + (tt * 64 + l2) * 16);
#pragma unroll
            for (int w8 = 1; w8 < 8; ++w8) v = v + *(const LAS f32x4*)(lds + ((w8 * 4 + tt) * 64 + l2) * 16);
            const int tokl = 16 * tt + 4 * (l2 >> 4), r = l2 & 15;
            const f32x4 rq = *(const f32x4*)(RS + tok0 + tokl);
#pragma unroll
            for (int i = 0; i < 4; ++i) al[(tokl + i) * 16 + r] = v[i] * rq[i]; }
        __syncthreads();
        float w[16];
#pragma unroll
        for (int r = 0; r < 16; ++r) w[r] = w_a2[r * 1024 + kcol];
        const float bias = b_a[kcol];
        float cum = 0.f;
        for (int t = 0; t < 64; ++t) {
            const LAS f32x4* ap = (const LAS f32x4*)(al + t * 16); const f32x4 a0 = ap[0], a1 = ap[1], a2 = ap[2], a3 = ap[3];
            float z = bias;
#pragma unroll
            for (int r = 0; r < 4; ++r) { z += a0[r] * w[r] + a1[r] * w[4 + r]; z += a2[r] * w[8 + r] + a3[r] * w[12 + r]; }
            cum += log_sigmoid(z) * (1.0f / 16.0f);
        }
        const float ltot = cum; cum = 0.f;
        for (int t8 = 0; t8 < 8; ++t8) {
            float kd[8];
#pragma unroll
            for (int e = 0; e < 8; ++e) {
                const int t = 8 * t8 + e;
                const LAS f32x4* ap = (const LAS f32x4*)(al + t * 16); const f32x4 a0 = ap[0], a1 = ap[1], a2 = ap[2], a3 = ap[3];
                float z = bias;
#pragma unroll
                for (int r = 0; r < 4; ++r) { z += a0[r] * w[r] + a1[r] * w[4 + r]; z += a2[r] * w[8 + r] + a3[r] * w[12 + r]; }
                cum += log_sigmoid(z) * (1.0f / 16.0f);
                kd[e] = bf2f(P1[(size_t)(tok0 + t) * P1_LD + P1_K + kcol]) * fexp(ltot - cum) * RS[tok0 + t];
            }
            u32x4 o; o.x = pk2(kd[0], kd[1]); o.y = pk2(kd[2], kd[3]); o.z = pk2(kd[4], kd[5]); o.w = pk2(kd[6], kd[7]);
            *(u32x4*)(KDT + (size_t)kcol * M + tok0 + 8 * t8) = o;
        }
        DEC[(size_t)bc * 1024 + kcol] = fexp(ltot);
    }
}

constexpr int SC_KDB = 144, SC_QB = 528, SC_KD_BYTES = 256 * SC_KDB, SC_DEC_OFF = SC_KD_BYTES + 64 * SC_QB, SC_BUF = SC_DEC_OFF + 1024, SC_PART = SC_BUF;
__device__ __forceinline__ void gla_scan_phase(const Params& p, const Ctx& cx, LAS unsigned char* lds) {
    const bf16_t* P1 = (const bf16_t*)(cx.ws + WS_P); const bf16_t* VT = (const bf16_t*)(cx.ws + WS_VT); const bf16_t* KDT = (const bf16_t*)(cx.ws + WS_KDT);
    const float* DEC = (const float*)(cx.ws + WS_DEC); bf16_t* O = (bf16_t*)(cx.ws + WS_O);
    const int tid = cx.tid, wave = cx.wave, lane = cx.lane, G = cx.G, fr = lane & 15, fq = lane >> 4;
    const int vt = wave & 1, kq = wave >> 1;
    for (int item = cx.bid; item < 256; item += G) {
        int bh, vg; if (G == 256) { const int r_ = item >> 3; bh = (item & 7) + 8 * (r_ >> 4); vg = r_ & 15; } else { bh = item >> 4; vg = item & 15; }
        const int b = bh >> 2, h = bh & 3, v0 = vg * 32 + vt * 16;
        const bf16_t* gk = KDT + (size_t)(h * 256 + (tid >> 3)) * M + b * T + (tid & 7) * 8;
        const bf16_t* gq = P1 + (size_t)(b * T + (tid >> 5)) * P1_LD + P1_Q + h * 256 + (tid & 31) * 8;
        const float* gd = DEC + (size_t)(b * 64) * 1024 + h * 256 + (tid & 63) * 4;
        const int lk = (tid >> 3) * SC_KDB + (tid & 7) * 16, lq = SC_KD_BYTES + (tid >> 5) * SC_QB + (tid & 31) * 16;
        u32x4 pk[4], pq[4]; f32x4 pd = (f32x4){0.f, 0.f, 0.f, 0.f};
        __syncthreads();
#pragma unroll
        for (int i = 0; i < 4; ++i) { pk[i] = *(const u32x4*)(gk + (size_t)i * 64 * M); pq[i] = *(const u32x4*)(gq + (size_t)i * 16 * P1_LD); }
        if (tid < 64) pd = *(const f32x4*)gd;
#pragma unroll
        for (int i = 0; i < 4; ++i) { *(LAS u32x4*)(lds + lk + i * 64 * SC_KDB) = pk[i]; *(LAS u32x4*)(lds + lq + i * 16 * SC_QB) = pq[i]; }
        if (tid < 64) *(LAS f32x4*)(lds + SC_DEC_OFF + tid * 16) = pd;
        __syncthreads();
        f32x4 S[4];
#pragma unroll
        for (int i = 0; i < 4; ++i) S[i] = (f32x4){0.f, 0.f, 0.f, 0.f};
        const bf16_t* vtrow = VT + (size_t)(h * 512 + v0 + fr) * M + b * T + 8 * fq;
        bf16x8 nv0 = *(const bf16x8*)vtrow, nv1 = *(const bf16x8*)(vtrow + 32);
        const LAS unsigned char* kdb = lds + (64 * kq + fr) * SC_KDB + 16 * fq;
        const LAS unsigned char* decl = lds + SC_DEC_OFF + 256 * kq + 16 * fq;
        const LAS unsigned char* qb = lds + SC_KD_BYTES + fr * SC_QB + 128 * kq + 8 * fq;
        LAS unsigned char* pw = lds + SC_PART + wave * 4096 + lane * 16;
        const LAS unsigned char* pr = lds + SC_PART + vt * 4096 + kq * 1024 + lane * 16;
        for (int c = 0; c < 64; ++c) {
            const int tokc = c * 64;
            const bf16x8 vf0 = nv0, vf1 = nv1;
            if (c + 1 < 64) {
#pragma unroll
                for (int i = 0; i < 4; ++i) { pk[i] = *(const u32x4*)(gk + (size_t)i * 64 * M + tokc + 64); pq[i] = *(const u32x4*)(gq + (size_t)i * 16 * P1_LD + (size_t)(tokc + 64) * P1_LD); }
                nv0 = *(const bf16x8*)(vtrow + tokc + 64); nv1 = *(const bf16x8*)(vtrow + tokc + 96); if (tid < 64) pd = *(const f32x4*)(gd + (size_t)(c + 1) * 1024);
            }
#pragma unroll
            for (int j = 0; j < 4; ++j) {
                const f32x4 d = *(const LAS f32x4*)(decl + 64 * j);
                const bf16x8 a0 = *(const LAS bf16x8*)(kdb + j * 16 * SC_KDB), a1 = *(const LAS bf16x8*)(kdb + j * 16 * SC_KDB + 64);
                f32x4 sv = S[j] * d;
                sv = mfma16(a0, vf0, sv); sv = mfma16(a1, vf1, sv); S[j] = sv;
            }
            bf16x8 sf[2];
#pragma unroll
            for (int ks = 0; ks < 2; ++ks) { u32x4 w; w.x = pk2(S[2 * ks][0], S[2 * ks][1]); w.y = pk2(S[2 * ks][2], S[2 * ks][3]); w.z = pk2(S[2 * ks + 1][0], S[2 * ks + 1][1]); w.w = pk2(S[2 * ks + 1][2], S[2 * ks + 1][3]);
                sf[ks] = __builtin_bit_cast(bf16x8, w); }
#pragma unroll
            for (int ct = 0; ct < 4; ++ct) {
                f32x4 o = (f32x4){0.f, 0.f, 0.f, 0.f};
#pragma unroll
                for (int ks = 0; ks < 2; ++ks) {
                    const u32x2 q0 = *(const LAS u32x2*)(qb + ct * 16 * SC_QB + 64 * ks), q1 = *(const LAS u32x2*)(qb + ct * 16 * SC_QB + 64 * ks + 32);
                    u32x4 qw; qw.x = q0.x; qw.y = q0.y; qw.z = q1.x; qw.w = q1.y;
                    o = mfma16(sf[ks], __builtin_bit_cast(bf16x8, qw), o);
                }
                *(LAS f32x4*)(pw + ct * 1024) = o;
            }
            __syncthreads();
            {
                f32x4 o = *(const LAS f32x4*)pr;
#pragma unroll
                for (int k2 = 1; k2 < 4; ++k2) o = o + *(const LAS f32x4*)(pr + k2 * 8192);
                u32x2 w; w.x = pk2(o[0] * 0.0625f, o[1] * 0.0625f); w.y = pk2(o[2] * 0.0625f, o[3] * 0.0625f);
                *(u32x2*)(O + (size_t)(b * T + tokc + 16 * kq + fr) * D + h * 512 + v0 + 4 * fq) = w;
            }
            if (c + 1 < 64) {
#pragma unroll
                for (int i = 0; i < 4; ++i) { *(LAS u32x4*)(lds + lk + i * 64 * SC_KDB) = pk[i]; *(LAS u32x4*)(lds + lq + i * 16 * SC_QB) = pq[i]; }
                if (tid < 64) *(LAS f32x4*)(lds + SC_DEC_OFF + tid * 16) = pd;
            }
            __syncthreads();
        }
    }
}

__device__ __forceinline__ void gla_normgate_phase(const Params& p, const Ctx& cx, int j) {
    const int wave = cx.wave, lane = cx.lane;
    const bf16_t* P1 = (const bf16_t*)(cx.ws + WS_P); const bf16_t* O = (const bf16_t*)(cx.ws + WS_O); bf16_t* A2 = (bf16_t*)(cx.ws + WS_H);
    const float* gn = p.in[7] + (size_t)j * 512 + lane * 8;
    const f32x4 g0 = *(const f32x4*)gn, g1 = *(const f32x4*)(gn + 4);
    const int gw = cx.bid * 8 + wave, NGW = cx.G * 8;
    u32x4 no[4], ng[4];
    if (gw < M) {
#pragma unroll
        for (int h = 0; h < 4; ++h) { no[h] = *(const u32x4*)(O + (size_t)gw * D + h * 512 + lane * 8); ng[h] = *(const u32x4*)(P1 + (size_t)gw * P1_LD + P1_G + h * 512 + lane * 8); }
    }
    for (int tok = gw; tok < M; tok += NGW) {
        u32x4 ovv[4], gvv[4];
#pragma unroll
        for (int h = 0; h < 4; ++h) { ovv[h] = no[h]; gvv[h] = ng[h]; }
        if (tok + NGW < M) {
#pragma unroll
            for (int h = 0; h < 4; ++h) { no[h] = *(const u32x4*)(O + (size_t)(tok + NGW) * D + h * 512 + lane * 8); ng[h] = *(const u32x4*)(P1 + (size_t)(tok + NGW) * P1_LD + P1_G + h * 512 + lane * 8); }
        }
#pragma unroll
        for (int h = 0; h < 4; ++h) {
            const u32x4 ov = ovv[h], gv = gvv[h];
            float v[8], g[8];
#pragma unroll
            for (int i = 0; i < 4; ++i) { v[2 * i] = bflo(ov[i]); v[2 * i + 1] = bfhi(ov[i]); g[2 * i] = bflo(gv[i]); g[2 * i + 1] = bfhi(gv[i]); }
            float ss = 0.f;
#pragma unroll
            for (int i = 0; i < 8; ++i) ss += v[i] * v[i];
            ss = wave_sum(ss);
            const float r = __builtin_amdgcn_rsqf(ss * (1.0f / 512.0f) + RMS_EPS);
            float y[8];
#pragma unroll
            for (int i = 0; i < 8; ++i) { const float gg = (i < 4) ? g0[i] : g1[i - 4]; y[i] = v[i] * r * gg * (g[i] * __builtin_amdgcn_rcpf(1.0f + fexp(-g[i]))); }
            u32x4 w; w.x = pk2(y[0], y[1]); w.y = pk2(y[2], y[3]); w.z = pk2(y[4], y[5]); w.w = pk2(y[6], y[7]);
            *(u32x4*)(A2 + (size_t)tok * D + h * 512 + lane * 8) = w;
        }
    }
}

__device__ __forceinline__ void dsa_post_phase(const Params& p, const Ctx& cx, int j) {
    const int wave = cx.wave, lane = cx.lane;
    const bf16_t* P2 = (const bf16_t*)(cx.ws + WS_P); bf16_t* CN = (bf16_t*)(cx.ws + WS_CN); bf16_t* KI = (bf16_t*)(cx.ws + WS_KI); float* WI = (float*)(cx.ws + WS_WI);
    const f32x4 kvn = *(const f32x4*)(p.in[10] + (size_t)j * 256 + lane * 4);
    const float kn0 = p.in[11][(size_t)j * 128 + lane * 2], kn1 = p.in[11][(size_t)j * 128 + lane * 2 + 1];
    const int gw = cx.bid * 8 + wave, NGW = cx.G * 8;
    for (int m = gw; m < M; m += NGW) {
        const bf16_t* row = P2 + (size_t)m * P2_LD;
        const u32x2 cv = *(const u32x2*)(row + P2_C + lane * 4);
        const float c0 = bflo(cv.x), c1 = bfhi(cv.x), c2 = bflo(cv.y), c3 = bfhi(cv.y);
        float ss = wave_sum((c0 * c0 + c1 * c1) + (c2 * c2 + c3 * c3));
        float r = 1.0f / sqrtf(ss * (1.0f / 256.0f) + RMS_EPS);
        u32x2 w; w.x = pk2(c0 * r * kvn[0], c1 * r * kvn[1]); w.y = pk2(c2 * r * kvn[2], c3 * r * kvn[3]);
        *(u32x2*)(CN + (size_t)m * 256 + lane * 4) = w;
        const unsigned kv = *(const unsigned*)(row + P2_KI + lane * 2);
        const float k0 = bflo(kv), k1 = bfhi(kv);
        ss = wave_sum(k0 * k0 + k1 * k1);
        r = 1.0f / sqrtf(ss * (1.0f / 128.0f) + RMS_EPS);
        *(unsigned*)(KI + (size_t)m * 128 + lane * 2) = pk2(k0 * r * kn0, k1 * r * kn1);
        if (lane < 16) WI[(size_t)m * 16 + lane] = bf2f(row[P2_WI + lane]) * (0.25f * 0.08838834764831845f);
    }
}

__device__ __forceinline__ void dsa_index_phase(const Params& p, const Ctx& cx, LAS unsigned char* lds) {
    const int wave = cx.wave, lane = cx.lane;
    const bf16_t* P2 = (const bf16_t*)(cx.ws + WS_P); const bf16_t* KI = (const bf16_t*)(cx.ws + WS_KI); const float* WI = (const float*)(cx.ws + WS_WI); int* IDX = (int*)(cx.ws + WS_IDX);
    const int G = cx.G;
    const int pair = wave >> 1, kh = wave & 1, rho = lane & 31, hA = lane >> 5;
    for (int k = 0;; ++k) {
        const int it = cx.bid + k * G; if (it >= 2048) break;
        int b, pos; if (G == 256) { b = k >> 1; pos = (k & 1) ? 511 - cx.bid : cx.bid; } else { b = it >> 9; pos = it & 511; }
        const int q0 = pos * 8, nch = (q0 >> 6) + 1, ntile = 2 * nch;
        {
            const int qA = q0 + 2 * pair + ((rho >> 2) & 1), headA = (rho & 3) + 4 * (rho >> 3);
            const bf16_t* qip = P2 + (size_t)(b * T + qA) * P2_LD + P2_QI + headA * 128 + 8 * hA;
            bf16x8 af[8];
#pragma unroll
            for (int s = 0; s < 8; ++s) af[s] = *(const bf16x8*)(qip + 16 * s);
            const float* wp = WI + (size_t)(b * T + q0 + 2 * pair + hA) * 16;
            f32x4 w4[4];
#pragma unroll
            for (int i = 0; i < 4; ++i) w4[i] = *(const f32x4*)(wp + 4 * i);
            LAS float* sc = (LAS float*)lds + (2 * pair + hA) * 4096;
            LAS unsigned char* stg = lds + 131072;
            const char* kub = (const char*)(KI + (size_t)(b * T) * 128);
            const unsigned kvo = (unsigned)(((cx.tid >> 4) * 128 + (cx.tid & 15) * 8) * 2);
#define KLD(TILE, HALF_) (*(const u32x4*)(kub + (size_t)(TILE) * 16384 + (size_t)(HALF_) * 8192 + kvo))
            const int sto = (cx.tid >> 4) * 272 + (cx.tid & 15) * 16;
            __builtin_amdgcn_s_waitcnt(0);
            u32x4 rA0 = KLD(0, 0), rA1 = KLD(0, 1), rB0 = rA0, rB1 = rA1;
            if (nch > 1) { rB0 = KLD(1, 0); rB1 = KLD(1, 1); }
            const LAS unsigned char* brd = stg + (kh * 32 + rho) * 272 + 16 * hA;
#define IDX_TILE(R0, R1, TILE) do { \
                __syncthreads(); \
                *(LAS u32x4*)(stg + sto) = R0; *(LAS u32x4*)(stg + sto + 32 * 272) = R1; \
                __syncthreads(); \
                if ((TILE) + 2 < nch) { R0 = KLD((TILE) + 2, 0); R1 = KLD((TILE) + 2, 1); } \
                bf16x8 bfr[8]; \
                _Pragma("unroll") for (int s = 0; s < 8; ++s) bfr[s] = *(const LAS bf16x8*)(brd + 32 * s); \
                f32x16 acc, acc2; \
                _Pragma("unroll") for (int i = 0; i < 16; ++i) { acc[i] = 0.f; acc2[i] = 0.f; } \
                _Pragma("unroll") for (int s = 0; s < 4; ++s) { acc = mfma32(af[2 * s], bfr[2 * s], acc); acc2 = mfma32(af[2 * s + 1], bfr[2 * s + 1], acc2); } \
                float v = 0.f, v2 = 0.f; \
                _Pragma("unroll") for (int i = 0; i < 16; i += 2) { v += w4[i >> 2][i & 3] * fmaxf(acc[i] + acc2[i], 0.f); v2 += w4[(i + 1) >> 2][(i + 1) & 3] * fmaxf(acc[i + 1] + acc2[i + 1], 0.f); } \
                v += v2; \
                sc[(TILE) * 64 + kh * 32 + rho] = v; } while (0)
            for (int tile = 0; tile < nch; tile += 2) {
                IDX_TILE(rA0, rA1, tile);
                if (tile + 1 < nch) IDX_TILE(rB0, rB1, tile + 1);
            }
#undef IDX_TILE
#undef KLD
        }
        __syncthreads();
        {
            const LAS unsigned* su = (const LAS unsigned*)lds + wave * 4096 + lane;
            unsigned u[64];
#pragma unroll
            for (int jj = 0; jj < 64; ++jj) { unsigned x = 0u; if (jj < nch) { const float sv_ = __builtin_bit_cast(float, su[jj * 64]);
                    const unsigned bits = (unsigned)__builtin_bit_cast(unsigned short, (_Float16)sv_) << 16; x = (bits & 0x80000000u) ? (~bits & 0xffff0000u) : (bits | 0x80000000u); } u[jj] = x; }
            int* ip = IDX + (size_t)(b * T + q0 + wave) * 256;
            if (nch <= 4) {
#pragma unroll
                for (int jj = 0; jj < 4; ++jj) ip[jj * 64 + lane] = (jj < nch) ? jj * 64 + lane : -1;
            } else {
                unsigned Tt = 0u;
                for (int bit = 31; bit >= 16; --bit) {
                    const unsigned cand = Tt | (1u << bit); int cnt = 0;
#pragma unroll
                    for (int g8 = 0; g8 < 8; ++g8) { if (g8 * 8 < nch) {
#pragma unroll
                        for (int jj = g8 * 8; jj < g8 * 8 + 8; ++jj) cnt += __builtin_popcountll(__ballot(u[jj] >= cand)); } }
                    if (cnt >= 256) Tt = cand;
                    if (cnt == 256) break;
                }
                int basep = 0;
#pragma unroll
                for (int jj = 0; jj < 64; ++jj) { if (jj >= nch) continue; const bool sel = u[jj] > Tt; const unsigned long long mk = __ballot(sel);
                    const int ps = basep + (int)__builtin_amdgcn_mbcnt_hi((unsigned)(mk >> 32), __builtin_amdgcn_mbcnt_lo((unsigned)mk, 0u));
                    if (sel) ip[ps] = jj * 64 + lane; basep += __builtin_popcountll(mk); }
#pragma unroll
                for (int jj = 0; jj < 64; ++jj) { if (jj >= nch) continue; const bool sel = u[jj] == Tt; const unsigned long long mk = __ballot(sel);
                    const int ps = basep + (int)__builtin_amdgcn_mbcnt_hi((unsigned)(mk >> 32), __builtin_amdgcn_mbcnt_lo((unsigned)mk, 0u));
                    if (sel && ps < 256) ip[ps] = jj * 64 + lane; basep += __builtin_popcountll(mk); }
            }
        }
        __syncthreads();
    }
}

constexpr int AT_ROWB = 528, AT_WAVEB = 32 * AT_ROWB, AT_BIAS = 8 * AT_WAVEB;
__device__ __forceinline__ s16x4 ld_tr(const LAS unsigned char* ptr) { return __builtin_bit_cast(s16x4, __builtin_amdgcn_ds_read_tr16_b64_v4i16((LAS s16x4*)ptr)); }
__device__ __forceinline__ int att_tok(const Ctx& cx, int k, int wloc) {
    if (cx.G == 256) return (k < 8) ? ((cx.bid & 7) >> 1) * T + k * 512 + wloc : -1;
    const int tok = cx.bid * 8 + cx.wave + k * cx.G * 8; return tok < M ? tok : -1;
}
#define ATT_GATHER(IR, SBLO, BB) do { const bf16_t* cb_ = CN + (size_t)(BB) * T * 256 + (lane & 31) * 8; _Pragma("unroll") for (int i_ = 0; i_ < 16; ++i_) { const int kidx_ = __shfl((IR), 32 * (SBLO) + 2 * i_ + (lane >> 5)); const unsigned kk_ = kidx_ < 0 ? 0u : (unsigned)kidx_; \
        g[i_] = *(const u32x4*)(cb_ + kk_ * 256u); if ((i_ & 3) == 3) asm volatile("" ::: "memory"); } } while (0)
__device__ __forceinline__ void dsa_attn_phase(const Params& p, const Ctx& cx, LAS unsigned char* lds) {
    const int wave = cx.wave, lane = cx.lane;
    const bf16_t* P2 = (const bf16_t*)(cx.ws + WS_P); const bf16_t* CN = (const bf16_t*)(cx.ws + WS_CN); const int* IDX = (const int*)(cx.ws + WS_IDX); bf16_t* OB = (bf16_t*)(cx.ws + WS_OB);
    LAS float* lb = (LAS float*)(lds + AT_BIAS);
    for (int e_ = cx.tid; e_ < 256 * 16; e_ += 512) { const int rel = (e_ >> 4) - 128, hd = e_ & 15, n = rel < 0 ? -rel : rel;
        const int large = 8 + (n >= 12) + (n >= 16) + (n >= 23) + (n >= 32) + (n >= 46) + (n >= 64) + (n >= 91);
        const int bk = ((rel > 0) ? 16 : 0) + ((n < 8) ? n : large);
        lb[e_] = p.in[14][bk * 16 + hd]; }
    __syncthreads();
    LAS unsigned char* wl = lds + wave * AT_WAVEB;
    const int fr = lane & 15, fq = lane >> 4;
    const int wloc = ((cx.bid & 1) * 32 + (cx.bid >> 3)) * 8 + wave;
    int tok = att_tok(cx, 0, wloc);
    int ir0 = 0, ir1 = 0, ir2 = 0, ir3 = 0;
    u32x4 g[16];
    if (tok >= 0) { const int* ip = IDX + (size_t)tok * 256 + lane; ir0 = ip[0]; ir1 = ip[64]; ir2 = ip[128]; ir3 = ip[192]; }
    for (int k = 0; tok >= 0; ++k) {
        const int b = tok >> 12, t = tok & (T - 1);
        const int ntok = att_tok(cx, k + 1, wloc);
        int nr0 = 0, nr1 = 0, nr2 = 0, nr3 = 0;
        if (ntok >= 0) { const int* ip = IDX + (size_t)ntok * 256 + lane; nr0 = ip[0]; nr1 = ip[64]; nr2 = ip[128]; nr3 = ip[192]; }
        const bf16_t* qp = P2 + (size_t)tok * P2_LD + P2_Q + fr * 256 + 8 * fq;
        float m_run = -INFINITY, l_run = 0.f;
        f32x4 oacc[16];
#pragma unroll
        for (int i = 0; i < 16; ++i) oacc[i] = (f32x4){0.f, 0.f, 0.f, 0.f};
        for (int sb = 0; sb < 8; ++sb) {
            const int h2 = sb >> 1, irc = (h2 == 0) ? ir0 : (h2 == 1) ? ir1 : (h2 == 2) ? ir2 : ir3;
            ATT_GATHER(irc, sb & 1, b);
#pragma unroll
            for (int i = 0; i < 16; ++i) *(LAS u32x4*)(wl + (2 * i + (lane >> 5)) * AT_ROWB + (lane & 31) * 16) = g[i];
            int kx[8];
#pragma unroll
            for (int e = 0; e < 8; ++e) kx[e] = __shfl(irc, 32 * (sb & 1) + 16 * (e >> 2) + 4 * fq + (e & 3));
            bf16x8 qf[8];
            { size_t qo_ = 0; asm volatile("" : "+s"(qo_));
#pragma unroll
              for (int s = 0; s < 8; ++s) qf[s] = *(const bf16x8*)(qp + qo_ + 32 * s); }
            asm volatile("s_waitcnt lgkmcnt(0)" ::: "memory");
            f32x4 sacc[2];
#pragma unroll
            for (int kt2 = 0; kt2 < 2; ++kt2) { f32x4 a = (f32x4){0.f, 0.f, 0.f, 0.f};
#pragma unroll
                for (int s = 0; s < 8; ++s) { const bf16x8 cf = *(const LAS bf16x8*)(wl + (16 * kt2 + fr) * AT_ROWB + (32 * s + 8 * fq) * 2); a = mfma16(cf, qf[s], a); if ((s & 3) == 3) asm volatile("" ::: "memory"); }
                sacc[kt2] = a; }
            float lg[8];
#pragma unroll
            for (int e = 0; e < 8; ++e) { const int kidx = kx[e]; const float a = ((e < 4) ? sacc[0][e & 3] : sacc[1][e & 3]) * 0.0625f;
                int rel = kidx - t; rel = rel < -128 ? -128 : (rel > 127 ? 127 : rel);
                const float bias = lb[(rel + 128) * 16 + fr];
                lg[e] = (kidx < 0) ? -INFINITY : a + bias; }
            float bm = fmaxf(fmaxf(fmaxf(lg[0], lg[1]), fmaxf(lg[2], lg[3])), fmaxf(fmaxf(lg[4], lg[5]), fmaxf(lg[6], lg[7])));
            bm = fmaxf(bm, __shfl_xor(bm, 16)); bm = fmaxf(bm, __shfl_xor(bm, 32));
            const float m_new = fmaxf(m_run, bm), scale = __expf(m_run - m_new);
            float pe[8], psum = 0.f;
#pragma unroll
            for (int e = 0; e < 8; ++e) { pe[e] = __expf(lg[e] - m_new); psum += pe[e]; }
            l_run = l_run * scale + psum; m_run = m_new;
#pragma unroll
            for (int i = 0; i < 16; ++i) oacc[i] = oacc[i] * scale;
            u32x4 pw; pw.x = pk2(pe[0], pe[1]); pw.y = pk2(pe[2], pe[3]); pw.z = pk2(pe[4], pe[5]); pw.w = pk2(pe[6], pe[7]);
            const bf16x8 pf = __builtin_bit_cast(bf16x8, pw);
            const LAS unsigned char* tb = wl + (4 * fq + ((lane & 15) >> 2)) * AT_ROWB + 8 * (lane & 3);
#pragma unroll
            for (int lt = 0; lt < 16; ++lt) {
                const s16x4 t0 = ld_tr(tb + 32 * lt), t1 = ld_tr(tb + 16 * AT_ROWB + 32 * lt);
                bf16x8 cf; cf[0] = t0[0]; cf[1] = t0[1]; cf[2] = t0[2]; cf[3] = t0[3]; cf[4] = t1[0]; cf[5] = t1[1]; cf[6] = t1[2]; cf[7] = t1[3];
                oacc[lt] = mfma16(cf, pf, oacc[lt]);
                if ((lt & 3) == 3) asm volatile("" ::: "memory");
            }
            asm volatile("s_waitcnt lgkmcnt(0)" ::: "memory");
        }
        float lt_ = l_run + __shfl_xor(l_run, 16); lt_ += __shfl_xor(lt_, 32);
        const float inv = 1.0f / lt_;
        bf16_t* op = OB + (size_t)tok * 4096 + fr * 256 + 4 * fq;
#pragma unroll
        for (int lt = 0; lt < 16; ++lt) { u32x2 w; w.x = pk2(oacc[lt][0] * inv, oacc[lt][1] * inv); w.y = pk2(oacc[lt][2] * inv, oacc[lt][3] * inv); *(u32x2*)(op + 16 * lt) = w; }
        tok = ntok; ir0 = nr0; ir1 = nr1; ir2 = nr2; ir3 = nr3;
    }
    __syncthreads();
}

#define XB_TMO      128
#define XB_XCNT(j)  (256  + 64 * (j))
#define XB_XSUB(j)  (1280 + 64 * (j))
#define XB_XGEN(j)  (2304 + 64 * (j))
#define XB_TOP      3328
#define XB_TOPGEN   3392
#define XCD_BAR_WORDS 3456
#define XB_SPIN_CAP (1u << 22)
__device__ __forceinline__ unsigned xb_ld(unsigned* p)              { return __hip_atomic_load(p, __ATOMIC_RELAXED, __HIP_MEMORY_SCOPE_AGENT); }
__device__ __forceinline__ unsigned xb_add(unsigned* p, unsigned v) { return __hip_atomic_fetch_add(p, v, __ATOMIC_RELAXED, __HIP_MEMORY_SCOPE_AGENT); }
__device__ __forceinline__ unsigned xb_xcc_id() { return (unsigned)__builtin_amdgcn_s_getreg((3 << 11) | 20) & 0xFu; }
#define XB_SPIN(cond, bar) do { unsigned _sp = 0; while (cond) { __builtin_amdgcn_s_sleep(1); \
    if ((++_sp & 255u) == 0u) { if (xb_ld(&(bar)[XB_TMO])) break; if (_sp > XB_SPIN_CAP) { atomicAdd(&(bar)[XB_TMO], 1u); break; } } } } while (0)
struct XcdBarrier { unsigned* bar; unsigned x; volatile LAS unsigned* st; };
__device__ __forceinline__ XcdBarrier xcd_barrier_post(unsigned* bar, volatile LAS unsigned* st) {
    XcdBarrier b; b.bar = bar; b.x = xb_xcc_id(); b.st = st;
    if (threadIdx.x == 0) (void)xb_add(&bar[XB_XCNT(b.x)], 1u);
    return b;
}
__device__ __forceinline__ void xcd_barrier_complete(unsigned* bar, unsigned x, unsigned& nloc, unsigned& nx) {
    const unsigned G = gridDim.x * gridDim.y * gridDim.z;
    unsigned sum, cnt, mine, sp = 0u;
    for (;;) {
        sum = 0u; cnt = 0u; mine = 0u;
#pragma unroll
        for (unsigned j = 0; j < 16; ++j) { const unsigned c = xb_ld(&bar[XB_XCNT(j)]); sum += c; cnt += (c > 0u) ? 1u : 0u; mine = (j == x) ? c : mine; }
        if (sum == G) break;
        __builtin_amdgcn_s_sleep(1);
        if ((++sp & 255u) == 0u) { if (xb_ld(&bar[XB_TMO])) break; if (sp > XB_SPIN_CAP) { atomicAdd(&bar[XB_TMO], 1u); break; } }
    }
    nloc = mine > 0u ? mine : 1u; nx = cnt > 0u ? cnt : 1u;
}
__device__ __forceinline__ void xcd_barrier(const XcdBarrier& b) {
    asm volatile("s_waitcnt vmcnt(0)" ::: "memory");
    __syncthreads();
    if (threadIdx.x == 0) {
        unsigned* bar = b.bar;
        __builtin_amdgcn_s_waitcnt(0);
        unsigned nloc = b.st[0], nx = b.st[1];
        if (nloc == 0u) { xcd_barrier_complete(bar, b.x, nloc, nx); b.st[0] = nloc; b.st[1] = nx; }
        const unsigned old = xb_add(&bar[XB_XSUB(b.x)], 1u);
        const unsigned gen = old / nloc;
        if (old + 1u == (gen + 1u) * nloc) {
            __builtin_amdgcn_fence(__ATOMIC_RELEASE, "agent");
            asm volatile("s_waitcnt vmcnt(0)" ::: "memory");
            const unsigned og = xb_add(&bar[XB_TOP], 1u);
            const unsigned tg = og / nx;
            if (og + 1u == (tg + 1u) * nx) xb_add(&bar[XB_TOPGEN], 1u);
            else XB_SPIN(xb_ld(&bar[XB_TOPGEN]) == tg, bar);
            __builtin_amdgcn_fence(__ATOMIC_ACQUIRE, "agent");
            xb_add(&bar[XB_XGEN(b.x)], 1u);
            asm volatile("s_waitcnt vmcnt(0)" ::: "memory");
        } else {
            XB_SPIN(xb_ld(&bar[XB_XGEN(b.x)]) == gen, bar);
            __builtin_amdgcn_fence(__ATOMIC_ACQUIRE, "agent");
            asm volatile("s_waitcnt vmcnt(0)" ::: "memory");
        }
    }
    __syncthreads();
}

constexpr int N_PHASES = 42;
__host__ __device__ inline bool phase_is_nop(int ph) { if (ph == 0 || ph == 41) return false; const int L = (ph - 1) / 10, s = (ph - 1) % 10; return (L == 0 && s == 0) || (L == 0 && s == 6); }

__host__ __device__ inline int phase_kind(int ph) {
    if (ph == 0) return 0; if (ph == 41) return 1;
    const int L = (ph - 1) / 10, s = (ph - 1) % 10; const bool gla = !(L & 1);
    if (s == 0 || s == 7) return 1; if (s == 1 || (!gla && s == 5)) return 2; if ((gla && s == 5) || (!gla && s == 6) || s == 9) return 3; if (s == 8) return 4;
    if (gla) return 3 + s; return 6 + s;
}
__global__ void __launch_bounds__(512, 2) trunk_fwd(Params p) {
    extern __shared__ __attribute__((aligned(16))) unsigned char smem[];
    LAS unsigned char* lds = (LAS unsigned char*)smem;
    volatile LAS unsigned* bst = (volatile LAS unsigned*)(lds + LDS_CTL);
    if (threadIdx.x < 64) bst[threadIdx.x] = 0u;
    __syncthreads();
    XcdBarrier gbar = xcd_barrier_post((unsigned*)p.ws, bst);
    if (p.ph_lo > 1000) cg::this_grid().sync();
    for (int ph = p.ph_lo, rep_ = 0; ph < p.ph_hi;) {
        if (phase_is_nop(ph)) { ++ph; continue; }
        int b_ = blockIdx.x; asm volatile("" : "+s"(b_)); int g_ = gridDim.x; asm volatile("" : "+s"(g_));
        size_t z_ = 0; asm volatile("" : "+s"(z_)); unsigned char* ws = p.ws + z_;
#define MKCX Ctx cx; { int t_ = threadIdx.x; asm volatile("" : "+v"(t_)); cx.tid = t_; cx.lane = t_ & 63; cx.wave = __builtin_amdgcn_readfirstlane(t_ >> 6); cx.bid = b_; cx.G = g_; cx.ws = ws; }
        bf16_t* Hb = (bf16_t*)(ws + WS_H); bf16_t* Pb = (bf16_t*)(ws + WS_P); bf16_t* XRp = (bf16_t*)(ws + WS_XR); const float* RSk = (const float*)(ws + WS_RSTD);
        if (ph == 0) { if (PHON(0)) { MKCX; prologue_phase(p, cx, lds, 0); } }
        else if (ph == 41) { if (PHON(1)) { MKCX; rms_phase<true, true>(ws + WS_XR, p.in[3], p.out, cx); } }
        else {
            const int L = (ph - 1) / 10, s = (ph - 1) % 10, j = L >> 1; const bool gla = !(L & 1);
            unsigned char* wg = ws + WS_W + j * GLA_STRIDE; unsigned char* wd = ws + DSA_BASE + j * DSA_STRIDE; unsigned char* wf = ws + FFN_BASE + L * FFN_STRIDE;
            if (s == 0) { if (PHON(1)) { MKCX; rstd_phase(cx); } }
            else if (s == 7) { if (PHON(1)) { MKCX; rstd_phase(cx); } }
            else if (s == 1 || (!gla && s == 5)) {
                const int ng = (gla && s == 1) ? 2 : 1;
                for (int gi = 0; gi < ng; ++gi) {
                    pg8::Gemm g; pg8::EpiStore E;
                    if (gla) {
                        if (gi == 0) { g = pg8::Gemm{XRp, (const bf16_t*)(wg + GLA_WINA), M, 4096, D, D, D, 0}; E = pg8::EpiStore{Pb, P1_LD, RSk}; }
                        else { g = pg8::Gemm{(const bf16_t*)(wg + GLA_WV), XRp, D, M, D, D, D, 0}; E = pg8::EpiStore{(bf16_t*)(ws + WS_VT), M, nullptr}; }
                    } else if (s == 1) { g = pg8::Gemm{XRp, (const bf16_t*)(wd + DSA_WIN), M, P2_LD, D, D, D, 0}; E = pg8::EpiStore{Pb, P2_LD, RSk}; }
                    else { g = pg8::Gemm{(const bf16_t*)(ws + WS_OB), (const bf16_t*)(wd + DSA_WUV), M, D, 512, 4096, 512, 512}; E = pg8::EpiStore{Hb, D, nullptr}; }
                    pg8::StaticOrder S; S.init(g.M, g.N, g_, b_); int t2_ = threadIdx.x; asm volatile("" : "+v"(t2_));
                    if (PHON(2)) pg8::gemm_phase(lds, g, S, E, t2_);
                }
            } else if ((gla && s == 5) || (!gla && s == 6) || s == 9) {
                pg8::Gemm g;
                if (s == 9) g = pg8::Gemm{Pb, (const bf16_t*)(wf + FFN_W2), M, D, FF, FF, FF, 0};
                else g = pg8::Gemm{Hb, (const bf16_t*)(gla ? wg + GLA_WOUT : wd + DSA_WOUT), M, D, D, D, D, 0};
                pg8::EpiResid E{XRp, (float*)(ws + WS_SS)};
                pg8::StaticOrder S; S.init(g.M, g.N, g_, b_); int t2_ = threadIdx.x; asm volatile("" : "+v"(t2_));
                if (PHON(3)) pg8::gemm_phase(lds, g, S, E, t2_);
            } else if (s == 8) {
                pg8::Gemm g{XRp, (const bf16_t*)(wf + FFN_W13), M, 2 * FF, D, D, D, 0};
                pg8::EpiSwiglu E{Pb, RSk};
                pg8::StaticOrder S; S.init(g.M, g.N, g_, b_); int t2_ = threadIdx.x; asm volatile("" : "+v"(t2_));
                if (PHON(4)) pg8::gemm_phase(lds, g, S, E, t2_);
            } else if (gla) {
                if (s == 2) { if (PHON(5)) { MKCX; gla_gate_phase(p, cx, j, lds); } }
                else if (s == 3) { if (PHON(6)) { MKCX; gla_scan_phase(p, cx, lds); } }
                else if (s == 4) { if (PHON(7)) { MKCX; gla_normgate_phase(p, cx, j); } }
                else if (s == 6) { if (PHON(0)) { MKCX; prologue_phase(p, cx, lds, 1); } }
            } else {
                if (s == 2) { if (PHON(8)) { MKCX; dsa_post_phase(p, cx, j); } }
                else if (s == 3) { if (PHON(9)) { MKCX; dsa_index_phase(p, cx, lds); } }
                else if (s == 4) { if (PHON(10)) { MKCX; dsa_attn_phase(p, cx, lds); } }
            }
        }
        if (ph + 1 < p.ph_hi) { xcd_barrier(gbar); if ((REP_MASK >> 11) & 1) xcd_barrier(gbar); }
        if (REP_MASK && rep_ == 0 && phase_kind(ph) != 3 && ((REP_MASK >> phase_kind(ph)) & 1)) rep_ = 1; else { rep_ = 0; ++ph; }
    }
}

extern "C" void kernel_launch(void* const* d_in, const int* in_sizes, int n_in, void* d_out, int out_size, void* d_ws, size_t ws_size, hipStream_t stream) {
    static int grid = 0;
    if (!grid) {
        if (n_in != 18 || out_size != M * D || ws_size < WS_END) { fprintf(stderr, "kernel_launch: unexpected shapes (n_in %d out %d ws %zu)\n", n_in, out_size, ws_size); grid = -1; return; }
        int dev = 0, cus = 0, per_cu = 0;
        hipGetDevice(&dev); hipDeviceGetAttribute(&cus, hipDeviceAttributeMultiprocessorCount, dev);
        if (hipFuncSetAttribute((const void*)trunk_fwd, hipFuncAttributeMaxDynamicSharedMemorySize, LDS_BYTES) != hipSuccess) { fprintf(stderr, "kernel_launch: hipFuncSetAttribute failed\n"); grid = -1; return; }
        hipOccupancyMaxActiveBlocksPerMultiprocessor(&per_cu, (const void*)trunk_fwd, 512, LDS_BYTES);
        if (per_cu < 1) per_cu = 1;
        grid = cus * per_cu;
        fprintf(stderr, "kernel_launch: grid %d (cus %d x %d)\n", grid, cus, per_cu);
    }
    if (grid < 0) return;
    if (hipMemsetAsync(d_ws, 0, XCD_BAR_WORDS * 4, stream) != hipSuccess) { fprintf(stderr, "kernel_launch: memset failed\n"); return; }
    Params p{};
    for (int i = 0; i < 18; ++i) p.in[i] = (const float*)d_in[i];
    p.out = (float*)d_out; p.ws = (unsigned char*)d_ws;
#if MK_MULTI
    for (int ph = 0; ph < N_PHASES; ++ph) {
        if (phase_is_nop(ph)) continue;
        p.ph_lo = ph; p.ph_hi = ph + 1;
        hipLaunchKernelGGL(trunk_fwd, dim3(grid), dim3(512), LDS_BYTES, stream, p);
    }
#else
    p.ph_lo = 0; p.ph_hi = N_PHASES;
    void* args[] = {&p};
    hipError_t e = hipLaunchCooperativeKernel((const void*)trunk_fwd, dim3(grid), dim3(512), args, LDS_BYTES, stream);
    if (e != hipSuccess) fprintf(stderr, "cooperative launch failed: %s (grid %d)\n", hipGetErrorString(e), grid);
#endif
}
```
